# Optimizing an MI355X kernel written in HIP

```python
import jax, jax.numpy as jnp
from jax import lax
import numpy as np

D_MODEL = 1024
BATCH = 8
SEQ = 2048
DEPTH = 1

ML_HEADS = 4
ML_DIM = D_MODEL
ML_HEAD_DIM = ML_DIM // ML_HEADS
ML_CHUNK = 64
CONV_WIDTH = 4
FOX_HEADS = 16
FOX_HEAD_DIM = 64
FOX_DIM = FOX_HEADS * FOX_HEAD_DIM
Q_BLOCK = 128
D_FF = 2816
EPS = 1e-6
SPLIT_SIZES = (ML_DIM, ML_DIM, ML_DIM, ML_DIM, ML_HEADS, ML_HEADS,
               FOX_DIM, FOX_DIM, FOX_DIM, FOX_HEADS, D_MODEL, D_MODEL)
N_IN = sum(SPLIT_SIZES)

kernel_name = 'macaron_mlstm_fox_gated_hybrid'


def _split_points():
    pts, acc = [], 0
    for s in SPLIT_SIZES[:-1]:
        acc += s
        pts.append(acc)
    return pts


def rmsnorm(x, g):
    xf = x.astype(jnp.float32)
    y = xf * lax.rsqrt(jnp.mean(xf * xf, axis=-1, keepdims=True) + EPS)
    return (y * g.astype(jnp.float32)).astype(x.dtype)


def swiglu(h, w_gate, w_up, w_down):
    return (jax.nn.silu(h @ w_gate) * (h @ w_up)) @ w_down


def causal_depthwise_conv(u, w, b):
    T = u.shape[1]
    up = jnp.pad(u, ((0, 0), (CONV_WIDTH - 1, 0), (0, 0)))
    y = b
    for j in range(CONV_WIDTH):
        y = y + up[:, j:j + T] * w[j]
    return y


def to_heads(u, n_heads):
    B, T, C = u.shape
    return u.reshape(B, T, n_heads, C // n_heads).transpose(0, 2, 1, 3)


def from_heads(u):
    B, H, T, Dh = u.shape
    return u.transpose(0, 2, 1, 3).reshape(B, T, H * Dh)


def mlstm_chunkwise(q, k, v, log_i, log_f):
    B, H, T, Dk = q.shape
    Dv = v.shape[-1]
    L = ML_CHUNK
    nc = T // L

    def to_chunks(a):
        return jnp.moveaxis(a.reshape(B, H, nc, L, *a.shape[3:]), 2, 0)

    xs = tuple(to_chunks(a) for a in (q, k, v, log_i, log_f))
    causal = jnp.tril(jnp.ones((L, L), dtype=bool))

    def step(carry, chunk):
        C, n, m = carry
        qx, kx, vx, ix, fx = chunk
        b = jnp.cumsum(fx, axis=-1)
        dmat = jnp.where(causal, b[..., :, None] - b[..., None, :] + ix[..., None, :], -jnp.inf)
        inter = b + m[..., None]
        m_t = jnp.maximum(jnp.max(dmat, axis=-1), inter)
        w_intra = jnp.exp(dmat - m_t[..., None])
        w_inter = jnp.exp(inter - m_t)
        s = jnp.einsum('bhtd,bhsd->bhts', qx, kx) * w_intra
        num = jnp.einsum('bhts,bhsv->bhtv', s, vx) + w_inter[..., None] * jnp.einsum('bhvd,bhtd->bhtv', C, qx)
        den = jnp.sum(s, axis=-1) + w_inter * jnp.einsum('bhd,bhtd->bht', n, qx)
        h = num / jnp.maximum(jnp.abs(den), jnp.exp(-m_t))[..., None]
        b_last = b[..., -1]
        log_w = b_last[..., None] - b + ix
        m_new = jnp.maximum(b_last + m, jnp.max(log_w, axis=-1))
        decay = jnp.exp(b_last + m - m_new)
        w = jnp.exp(log_w - m_new[..., None])
        C_new = decay[..., None, None] * C + jnp.einsum('bhsv,bhsd->bhvd', vx * w[..., None], kx)
        n_new = decay[..., None] * n + jnp.einsum('bhs,bhsd->bhd', w, kx)
        return (C_new, n_new, m_new), h

    init = (jnp.zeros((B, H, Dv, Dk), jnp.float32),
            jnp.zeros((B, H, Dk), jnp.float32),
            jnp.zeros((B, H), jnp.float32))
    _, hc = lax.scan(step, init, xs)
    return jnp.moveaxis(hc, 0, 2).reshape(B, H, T, Dv)


def forgetting_attention(q, k, v, log_f):
    T = q.shape[2]
    c = jnp.cumsum(log_f, axis=-1)
    scale = FOX_HEAD_DIM ** -0.5
    outs = []
    for blk in range(T // Q_BLOCK):
        q0 = blk * Q_BLOCK
        q1 = q0 + Q_BLOCK
        logits = (jnp.einsum('bhtd,bhsd->bhts', q[:, :, q0:q1], k[:, :, :q1]) * scale
                  + c[:, :, q0:q1, None] - c[:, :, None, :q1])
        mask = (q0 + jnp.arange(Q_BLOCK))[:, None] >= jnp.arange(q1)[None, :]
        p = jax.nn.softmax(jnp.where(mask, logits, -jnp.inf), axis=-1)
        outs.append(jnp.einsum('bhts,bhsd->bhtd', p, v[:, :, :q1]))
    return jnp.concatenate(outs, axis=2)


def headwise_layernorm(h, g):
    mu = jnp.mean(h, axis=-1, keepdims=True)
    var = jnp.mean(jnp.square(h - mu), axis=-1, keepdims=True)
    hn = (h - mu) * lax.rsqrt(var + EPS)
    return from_heads(hn) * g.astype(jnp.float32)


def setup_inputs(seed: int = 0) -> dict:
    key = jax.random.key(seed)
    ks = jax.random.split(key, 20)
    f32 = jnp.float32
    d = D_MODEL

    def w(k, shape, fan_in):
        return jax.random.normal(k, shape, f32) * fan_in ** -0.5

    def gain(k, shape):
        return 1.0 + 0.02 * jax.random.normal(k, shape, f32)

    x = jax.random.normal(ks[0], (BATCH, SEQ, d), f32)
    pts = [0] + _split_points()
    ml_f0 = pts[5]
    fx_f0 = pts[9]
    b_in = 0.02 * jax.random.normal(ks[1], (DEPTH, N_IN), f32)
    b_in = b_in.at[:, ml_f0:ml_f0 + ML_HEADS].add(jnp.linspace(3.0, 6.0, ML_HEADS, dtype=f32))
    b_in = b_in.at[:, fx_f0:fx_f0 + FOX_HEADS].add(jnp.linspace(1.0, 4.0, FOX_HEADS, dtype=f32))
    return {
        'x': x,
        'ffn1_norm': gain(ks[2], (DEPTH, d)),
        'ffn1_w_gate': w(ks[3], (DEPTH, d, D_FF), d),
        'ffn1_w_up': w(ks[4], (DEPTH, d, D_FF), d),
        'ffn1_w_down': w(ks[5], (DEPTH, D_FF, d), D_FF),
        'mix_norm': gain(ks[6], (DEPTH, d)),
        'w_in': w(ks[7], (DEPTH, d, N_IN), d),
        'b_in': b_in,
        'conv_w': w(ks[8], (DEPTH, CONV_WIDTH, 2 * ML_DIM), CONV_WIDTH),
        'conv_b': 0.02 * jax.random.normal(ks[9], (DEPTH, 2 * ML_DIM), f32),
        'ml_head_norm': gain(ks[10], (DEPTH, ML_DIM)),
        'w_out': w(ks[11], (DEPTH, d, d), d),
        'ffn2_norm': gain(ks[12], (DEPTH, d)),
        'ffn2_w_gate': w(ks[13], (DEPTH, d, D_FF), d),
        'ffn2_w_up': w(ks[14], (DEPTH, d, D_FF), d),
        'ffn2_w_down': w(ks[15], (DEPTH, D_FF, d), D_FF),
        'final_norm': gain(ks[16], (d,)),
    }


def reference(x, ffn1_norm, ffn1_w_gate, ffn1_w_up, ffn1_w_down, mix_norm, w_in, b_in,
              conv_w, conv_b, ml_head_norm, w_out, ffn2_norm, ffn2_w_gate, ffn2_w_up,
              ffn2_w_down, final_norm):
    f32 = jnp.float32
    for l in range(DEPTH):
        x = x + 0.5 * swiglu(rmsnorm(x, ffn1_norm[l]), ffn1_w_gate[l], ffn1_w_up[l], ffn1_w_down[l])

        h = rmsnorm(x, mix_norm[l])
        proj = (h @ w_in[l] + b_in[l]).astype(f32)
        (ml_q, ml_k, ml_v, ml_o, ml_i, ml_f,
         fx_q, fx_k, fx_v, fx_f, g_a, g_b) = jnp.split(proj, _split_points(), axis=-1)

        qk = jax.nn.silu(causal_depthwise_conv(jnp.concatenate([ml_q, ml_k], axis=-1),
                                               conv_w[l].astype(f32), conv_b[l].astype(f32)))
        q_a = to_heads(qk[..., :ML_DIM], ML_HEADS)
        k_a = to_heads(qk[..., ML_DIM:], ML_HEADS) * ML_HEAD_DIM ** -0.5
        v_a = to_heads(ml_v, ML_HEADS)
        log_i = ml_i.transpose(0, 2, 1)
        log_f_a = jax.nn.log_sigmoid(ml_f).transpose(0, 2, 1)
        h_a = mlstm_chunkwise(q_a, k_a, v_a, log_i, log_f_a)
        y_a = jax.nn.sigmoid(ml_o) * headwise_layernorm(h_a, ml_head_norm[l])

        log_f_b = jax.nn.log_sigmoid(fx_f).transpose(0, 2, 1)
        h_b = forgetting_attention(to_heads(fx_q, FOX_HEADS), to_heads(fx_k, FOX_HEADS),
                                   to_heads(fx_v, FOX_HEADS), log_f_b)
        y_b = from_heads(h_b)

        y = jax.nn.sigmoid(g_a) * y_a + jax.nn.sigmoid(g_b) * y_b
        x = x + y.astype(x.dtype) @ w_out[l]

        x = x + 0.5 * swiglu(rmsnorm(x, ffn2_norm[l]), ffn2_w_gate[l], ffn2_w_up[l], ffn2_w_down[l])
    return rmsnorm(x, final_norm)
```

```cpp
#include <hip/hip_runtime.h>
#include <hip/hip_cooperative_groups.h>
#include <cstdio>
#include <cstdint>
#include <cmath>
namespace pg8 {
#define PG8_LAS __attribute__((address_space(3)))
typedef unsigned short bf16_t;
typedef short bf16x8 __attribute__((ext_vector_type(8)));
typedef float f32x4 __attribute__((ext_vector_type(4)));
typedef unsigned u32x4 __attribute__((ext_vector_type(4)));
constexpr int BM = 256, BK = 64, HALF = 128, HTB = HALF * BK * 2  , STAGE_BYTES = 8 * HTB, NXCD = 8, WGM = 8;

__host__ __device__ __forceinline__ int lds_byte(int r, int c) { const int st = (r >> 4) * 2 + (c >> 5), rr = r & 15, cc = c & 31, ob = rr * 64 + cc * 2; return st * 1024 + (ob ^ (((ob >> 9) & 1) << 5)); }
__host__ __device__ __forceinline__ void stage_rc(int b, int& R, int& C) { const int st = b / 1024, sb = b % 1024, swz = sb ^ (((sb >> 9) & 1) << 5); R = (st >> 1) * 16 + swz / 64; C = (st & 1) * 32 + (swz % 64) / 2; }
__host__ __device__ __forceinline__ int perm32(int rho) { const int n = rho >> 4, i = rho & 15; return 8 * (i >> 2) + 4 * n + (i & 3); }

struct Unit { int pm, pn; };
struct Gemm { const bf16_t* A; const bf16_t* Bt; int M, N, K; };

struct StaticOrder {
    int nM, nN, nwg, G, c;
    __host__ __device__ void init(int M, int N, int G_, int c_) { nM = M / BM; nN = N / BM; nwg = nM * nN; G = G_; c = c_; }
    __host__ __device__ bool next(int i, Unit& u) const {
        const long L = (long)i * G + c; if (L >= nwg) return false;
        int wgid = (int)L; { const int q = nwg / NXCD, r = nwg % NXCD, xcd = wgid % NXCD, off = wgid / NXCD; wgid = (xcd < r ? xcd * (q + 1) : r * (q + 1) + (xcd - r) * q) + off; }
        const int nig = WGM * nN, gid = wgid / nig, fm = gid * WGM, gsz = (nM - fm) < WGM ? (nM - fm) : WGM;
        u.pm = fm + ((wgid % nig) % gsz); u.pn = (wgid % nig) / gsz; return true;
    }
    __device__ __forceinline__ void a_ready(const Unit&) const {}
    __device__ __forceinline__ void done(const Unit&) const {}
};

__device__ __forceinline__ unsigned cvt_pk_bf16(float lo, float hi) { unsigned r; asm volatile("v_cvt_pk_bf16_f32 %0, %1, %2" : "=v"(r) : "v"(lo), "v"(hi)); return r; }
typedef float f32x2 __attribute__((ext_vector_type(2)));
typedef unsigned u32x2 __attribute__((ext_vector_type(2)));
constexpr float RMS_EPS = 1e-6f, INV_D = 1.0f / 1024.0f, LOG2E = 1.4426950408889634f;
__device__ __forceinline__ float sigm(float x) { return __builtin_amdgcn_rcpf(1.f + __builtin_amdgcn_exp2f(-LOG2E * x)); }
__device__ __forceinline__ float bf_lo(unsigned w) { return __uint_as_float(w << 16); }
__device__ __forceinline__ float bf_hi(unsigned w) { return __uint_as_float(w & 0xffff0000u); }

struct EpiSwiGLU {
    static constexpr bool PERM = true, AFTER_DRAIN = false;
    bf16_t* H; int ldh; const float* ss;
    __device__ __forceinline__ void operator()(const f32x4 (&acc)[2][2][4][2], const Unit& u, int wr, int wc, int fr, int fq) const {
        const int row0 = u.pm * BM + wr * 64 + fr, col0 = u.pn * 128 + wc * 32 + 8 * fq;
#pragma unroll
        for (int ai = 0; ai < 2; ++ai)
#pragma unroll
            for (int m = 0; m < 4; ++m) { const int row = row0 + ai * HALF + m * 16; const float rs = __builtin_amdgcn_rsqf(ss[row] * INV_D + RMS_EPS);
                const f32x4 g0 = acc[ai][0][m][0] * rs, g1 = acc[ai][0][m][1] * rs, p0 = acc[ai][1][m][0] * rs, p1 = acc[ai][1][m][1] * rs;
                u32x4 w;
                w.x = cvt_pk_bf16(g0[0] * sigm(g0[0]) * p0[0], g0[1] * sigm(g0[1]) * p0[1]); w.y = cvt_pk_bf16(g0[2] * sigm(g0[2]) * p0[2], g0[3] * sigm(g0[3]) * p0[3]);
                w.z = cvt_pk_bf16(g1[0] * sigm(g1[0]) * p1[0], g1[1] * sigm(g1[1]) * p1[1]); w.w = cvt_pk_bf16(g1[2] * sigm(g1[2]) * p1[2], g1[3] * sigm(g1[3]) * p1[3]);
                *(u32x4*)(H + (size_t)row * ldh + col0) = w; }
    }
};

struct EpiResid {
    static constexpr bool PERM = true, AFTER_DRAIN = false;
    const float* base; float* out; bf16_t* xb; float* ssout; float alpha;
    __device__ __forceinline__ void operator()(const f32x4 (&acc)[2][2][4][2], const Unit& u, int wr, int wc, int fr, int fq) const {
        const int row0 = u.pm * BM + wr * 64 + fr, col0 = u.pn * BM + wc * 32 + 8 * fq;
#pragma unroll
        for (int ai = 0; ai < 2; ++ai)
#pragma unroll
            for (int m = 0; m < 4; ++m) { const int row = row0 + ai * HALF + m * 16; float q = 0.f;
#pragma unroll
                for (int bj = 0; bj < 2; ++bj) { const size_t off = (size_t)row * 1024 + col0 + bj * HALF;
                    const f32x4 b0 = *(const f32x4*)(base + off), b1 = *(const f32x4*)(base + off + 4);
                    const f32x4 o0 = b0 + acc[ai][bj][m][0] * alpha, o1 = b1 + acc[ai][bj][m][1] * alpha;
                    *(f32x4*)(out + off) = o0; *(f32x4*)(out + off + 4) = o1;
                    if (xb) { u32x4 w; w.x = cvt_pk_bf16(o0[0], o0[1]); w.y = cvt_pk_bf16(o0[2], o0[3]); w.z = cvt_pk_bf16(o1[0], o1[1]); w.w = cvt_pk_bf16(o1[2], o1[3]); *(u32x4*)(xb + off) = w; }
                    q += (o0[0] * o0[0] + o0[1] * o0[1]) + (o0[2] * o0[2] + o0[3] * o0[3]) + (o1[0] * o1[0] + o1[1] * o1[1]) + (o1[2] * o1[2] + o1[3] * o1[3]); }
                q += __shfl_xor(q, 16); q += __shfl_xor(q, 32);
                if (fq == 0) unsafeAtomicAdd(ssout + row, q);
                asm volatile("" ::: "memory"); }
    }
};

struct EpiInA {
    static constexpr bool PERM = true, AFTER_DRAIN = false;
    bf16_t* P; size_t slot_stride; float* gates; const float* bias; const float* ss; float qscale;
    __device__ __forceinline__ void operator()(const f32x4 (&acc)[2][2][4][2], const Unit& u, int wr, int wc, int fr, int fq) const {
        const int row0 = u.pm * BM + wr * 64 + fr, colt = u.pn * BM;
        if (colt >= 6144) {
            if (wc == 0) { const f32x4 bv0 = *(const f32x4*)(bias + colt + 8 * fq), bv1 = *(const f32x4*)(bias + colt + 8 * fq + 4);
#pragma unroll
                for (int ai = 0; ai < 2; ++ai)
#pragma unroll
                    for (int m = 0; m < 4; ++m) { const int row = row0 + ai * HALF + m * 16; const float rs = __builtin_amdgcn_rsqf(ss[row] * INV_D + RMS_EPS);
                        *(f32x4*)(gates + (size_t)row * 32 + 8 * fq) = acc[ai][0][m][0] * rs + bv0; *(f32x4*)(gates + (size_t)row * 32 + 8 * fq + 4) = acc[ai][0][m][1] * rs + bv1; } }
            return; }
        const int slot = colt >> 10, cb = (colt & 1023) + wc * 32 + 8 * fq; const float sc = (slot == 3) ? qscale : 1.f;
        bf16_t* O = P + (size_t)slot * slot_stride;
        f32x4 bv[2][2];
#pragma unroll
        for (int bj = 0; bj < 2; ++bj)
#pragma unroll
            for (int n = 0; n < 2; ++n) bv[bj][n] = *(const f32x4*)(bias + colt + bj * HALF + wc * 32 + 8 * fq + 4 * n);
#pragma unroll
        for (int ai = 0; ai < 2; ++ai)
#pragma unroll
            for (int m = 0; m < 4; ++m) { const int row = row0 + ai * HALF + m * 16; const float rs = __builtin_amdgcn_rsqf(ss[row] * INV_D + RMS_EPS);
#pragma unroll
                for (int bj = 0; bj < 2; ++bj) { const f32x4 v0 = (acc[ai][bj][m][0] * rs + bv[bj][0]) * sc, v1 = (acc[ai][bj][m][1] * rs + bv[bj][1]) * sc;
                    u32x4 w; w.x = cvt_pk_bf16(v0[0], v0[1]); w.y = cvt_pk_bf16(v0[2], v0[3]); w.z = cvt_pk_bf16(v1[0], v1[1]); w.w = cvt_pk_bf16(v1[2], v1[3]);
                    *(u32x4*)(O + (size_t)row * 1024 + cb + bj * HALF) = w; } }
    }
};

struct EpiInB {
    static constexpr bool PERM = true, AFTER_DRAIN = false;
    const bf16_t* ha; const bf16_t* yb; const float* stats; const float* gn; const float* bias; const float* ss; bf16_t* Y;
    __device__ __forceinline__ void operator()(const f32x4 (&acc)[2][2][4][2], const Unit& u, int wr, int wc, int fr, int fq) const {
        const int row0 = u.pm * BM + wr * 64 + fr, j = u.pn * 64 + wc * 16 + 4 * fq, head = j >> 8, cb = u.pn * BM + wc * 32 + 8 * fq;
        const f32x4 bmo = *(const f32x4*)(bias + cb), bga = *(const f32x4*)(bias + cb + 4), bgb = *(const f32x4*)(bias + cb + HALF), gnv = *(const f32x4*)(gn + j);
#pragma unroll
        for (int ai = 0; ai < 2; ++ai)
#pragma unroll
            for (int m = 0; m < 4; ++m) { const int row = row0 + ai * HALF + m * 16; const float rs = __builtin_amdgcn_rsqf(ss[row] * INV_D + RMS_EPS);
                const f32x4 mo = acc[ai][0][m][0] * rs + bmo, ga = acc[ai][0][m][1] * rs + bga, gb = acc[ai][1][m][0] * rs + bgb;
                const float s1 = stats[((size_t)row * 4 + head) * 2], s2 = stats[((size_t)row * 4 + head) * 2 + 1];
                const float mean = s1 * (1.f / 256.f), var = fmaxf(s2 * (1.f / 256.f) - mean * mean, 0.f), rln = __builtin_amdgcn_rsqf(var + RMS_EPS);
                const u32x2 hw = *(const u32x2*)(ha + (size_t)row * 1024 + j), yw = *(const u32x2*)(yb + (size_t)row * 1024 + j);
                const f32x4 hv = {bf_lo(hw.x), bf_hi(hw.x), bf_lo(hw.y), bf_hi(hw.y)}, yv = {bf_lo(yw.x), bf_hi(yw.x), bf_lo(yw.y), bf_hi(yw.y)};
                f32x4 y;
#pragma unroll
                for (int i = 0; i < 4; ++i) y[i] = sigm(ga[i]) * sigm(mo[i]) * ((hv[i] - mean) * rln * gnv[i]) + sigm(gb[i]) * yv[i];
                u32x2 w; w.x = cvt_pk_bf16(y[0], y[1]); w.y = cvt_pk_bf16(y[2], y[3]);
                *(u32x2*)(Y + (size_t)row * 1024 + j) = w; }
    }
};

template <class Epi, class Sched, bool ALIGN_EPI = false, bool SP2 = false>
__device__ __forceinline__ void gemm_phase(PG8_LAS unsigned char* lds, const Gemm g, const Sched& S, const Epi& E) {
    const int tid = threadIdx.x, wid = __builtin_amdgcn_readfirstlane(tid >> 6), lane = tid & 63, wr = wid >> 2, wc = wid & 3, fr = lane & 15, fq = lane >> 4;
    const int K = g.K, nt = K / BK;
    unsigned voffA[2], voffB[2];
#pragma unroll
    for (int i = 0; i < 2; ++i) { int R, C; stage_rc(tid * 16 + i * 8192, R, C); const int Rb = Epi::PERM ? ((R & ~31) + perm32(R & 31)) : R;
        voffA[i] = (unsigned)(R * K + C) * 2u; voffB[i] = (unsigned)(Rb * K + C) * 2u; }
    const size_t kstep = (size_t)(BK * 2);
    const size_t hstep = (size_t)HALF * K * 2;
    const size_t tstep = 2 * hstep;
    const unsigned ldsw = (unsigned)wid * 1024u;
    const int aoff = lds_byte(wr * 64 + fr, fq * 8), boff = lds_byte(wc * 32 + fr, fq * 8);
#define PG8_SA(b, h) (((b) * 2 + (h)) * HTB)
#define PG8_SB(b, h) ((4 + (b) * 2 + (h)) * HTB)
#define PG8_STAGE(bufoff, gbase, voff) do { _Pragma("unroll") for (int _i = 0; _i < 2; ++_i) \
        __builtin_amdgcn_global_load_lds((const unsigned*)((const char*)(gbase) + (voff)[_i]), (PG8_LAS unsigned*)(lds + (bufoff) + ldsw + _i * 8192), 16, 0, 0); } while (0)
#define PG8_LDA(dst, b, h) do { _Pragma("unroll") for (int m = 0; m < 4; ++m) _Pragma("unroll") for (int k = 0; k < 2; ++k) dst[m][k] = *(const PG8_LAS bf16x8*)(lds + PG8_SA(b, h) + aoff + m * 2048 + k * 1024); } while (0)
#define PG8_LDB(dst, b, h) do { _Pragma("unroll") for (int n = 0; n < 2; ++n) _Pragma("unroll") for (int k = 0; k < 2; ++k) dst[n][k] = *(const PG8_LAS bf16x8*)(lds + PG8_SB(b, h) + boff + n * 2048 + k * 1024); } while (0)
#define PG8_MMA(ai, bj, At, Bt) do { __builtin_amdgcn_s_setprio(1); _Pragma("unroll") for (int m = 0; m < 4; ++m) _Pragma("unroll") for (int n = 0; n < 2; ++n) _Pragma("unroll") for (int k = 0; k < 2; ++k) \
        acc[ai][bj][m][n] = __builtin_amdgcn_mfma_f32_16x16x32_bf16(Bt[n][k], At[m][k], acc[ai][bj][m][n], 0, 0, 0); __builtin_amdgcn_s_setprio(0); } while (0)
#define PG8_WAIT_V(n) asm volatile("s_waitcnt vmcnt(" #n ")" ::: "memory")
#define PG8_WAIT_L(n) asm volatile("s_waitcnt lgkmcnt(" #n ")" ::: "memory")
#define PG8_BAR __builtin_amdgcn_s_barrier()
#define PG8_SCHED __builtin_amdgcn_sched_barrier(0)
    Unit cur, nxt; int ui = 0;
    if (!S.next(0, cur)) return;
    f32x4 acc[2][2][4][2];
#pragma unroll
    for (int a = 0; a < 2; ++a)
#pragma unroll
        for (int b = 0; b < 2; ++b)
#pragma unroll
            for (int m = 0; m < 4; ++m)
#pragma unroll
                for (int n = 0; n < 2; ++n) acc[a][b][m][n] = (f32x4){0.f, 0.f, 0.f, 0.f};
    bf16x8 At[4][2], B0[2][2], B1[2][2];
    const char* cA = (const char*)g.A + (size_t)cur.pm * tstep; const char* cB = (const char*)g.Bt + (size_t)cur.pn * tstep;
    S.a_ready(cur);
    if constexpr (SP2) {
        PG8_STAGE(PG8_SB(0, 0), cB, voffB); PG8_STAGE(PG8_SB(0, 1), cB + hstep, voffB); PG8_STAGE(PG8_SA(0, 0), cA, voffA); PG8_STAGE(PG8_SA(0, 1), cA + hstep, voffA);
        if (wr == 1) PG8_BAR;
        PG8_WAIT_V(2); PG8_BAR;
        PG8_STAGE(PG8_SB(1, 0), cB + kstep, voffB); PG8_STAGE(PG8_SA(1, 0), cA + kstep, voffA); PG8_STAGE(PG8_SB(1, 1), cB + hstep + kstep, voffB);
        PG8_WAIT_V(6); PG8_BAR;
    } else {
        PG8_STAGE(PG8_SB(0, 0), cB, voffB); PG8_STAGE(PG8_SA(0, 0), cA, voffA); PG8_STAGE(PG8_SB(0, 1), cB + hstep, voffB); PG8_STAGE(PG8_SA(0, 1), cA + hstep, voffA);
        if (wr == 1) PG8_BAR;
        PG8_WAIT_V(4); PG8_BAR;
        PG8_STAGE(PG8_SB(1, 0), cB + kstep, voffB); PG8_STAGE(PG8_SA(1, 0), cA + kstep, voffA); PG8_STAGE(PG8_SB(1, 1), cB + hstep + kstep, voffB);
        PG8_WAIT_V(6); PG8_BAR;
    }
    for (;;) {
        const bool has_next = S.next(ui + 1, nxt);
        const char* nA = has_next ? (const char*)g.A + (size_t)nxt.pm * tstep : cA; const char* nB = has_next ? (const char*)g.Bt + (size_t)nxt.pn * tstep : cB;
        for (int t = 0; t < nt; t += 2) {
            const bool last = (t == nt - 2);
            const char* a1 = cA + (size_t)(t + 1) * kstep;
            const char* a2 = last ? nA : cA + (size_t)(t + 2) * kstep; const char* b2 = last ? nB : cB + (size_t)(t + 2) * kstep;
            const char* a3 = a2 + kstep; const char* b3 = b2 + kstep;
            if (last && has_next) S.a_ready(nxt);
            if constexpr (SP2) {
            PG8_LDB(B0, 0, 0); PG8_LDB(B1, 0, 1); PG8_SCHED; PG8_LDA(At, 0, 0); PG8_STAGE(PG8_SA(1, 1), a1 + hstep, voffA);
            PG8_WAIT_V(8); PG8_WAIT_L(0); PG8_BAR; PG8_MMA(0, 0, At, B0); PG8_MMA(0, 1, At, B1); PG8_BAR; PG8_SCHED;
            PG8_LDA(At, 0, 1); PG8_STAGE(PG8_SB(0, 0), b2, voffB); PG8_STAGE(PG8_SB(0, 1), b2 + hstep, voffB); PG8_STAGE(PG8_SA(0, 0), a2, voffA);
            PG8_WAIT_V(8); PG8_WAIT_L(0); PG8_BAR; PG8_MMA(1, 0, At, B0); PG8_MMA(1, 1, At, B1); PG8_BAR; PG8_SCHED;
            PG8_LDB(B0, 1, 0); PG8_LDB(B1, 1, 1); PG8_SCHED; PG8_LDA(At, 1, 0); PG8_STAGE(PG8_SA(0, 1), a2 + hstep, voffA);
            PG8_WAIT_V(8); PG8_WAIT_L(0); PG8_BAR; PG8_MMA(0, 0, At, B0); PG8_MMA(0, 1, At, B1); PG8_BAR; PG8_SCHED;
            PG8_LDA(At, 1, 1); PG8_STAGE(PG8_SB(1, 0), b3, voffB); PG8_STAGE(PG8_SB(1, 1), b3 + hstep, voffB); PG8_STAGE(PG8_SA(1, 0), a3, voffA);
            PG8_WAIT_V(8); PG8_WAIT_L(0); PG8_BAR; PG8_MMA(1, 0, At, B0); PG8_MMA(1, 1, At, B1); PG8_BAR; PG8_SCHED;
            } else {
            PG8_LDB(B0, 0, 0); PG8_SCHED; PG8_LDA(At, 0, 0); PG8_STAGE(PG8_SA(1, 1), a1 + hstep, voffA);
            PG8_WAIT_L(8); PG8_BAR; PG8_WAIT_L(0); PG8_MMA(0, 0, At, B0); PG8_BAR; PG8_SCHED;
            PG8_LDB(B1, 0, 1); PG8_STAGE(PG8_SB(0, 0), b2, voffB);
            PG8_BAR; PG8_WAIT_L(0); PG8_MMA(0, 1, At, B1); PG8_BAR;
            PG8_LDA(At, 0, 1); PG8_STAGE(PG8_SA(0, 0), a2, voffA);
            PG8_BAR; PG8_WAIT_L(0); PG8_MMA(1, 0, At, B0); PG8_BAR; PG8_SCHED;
            PG8_STAGE(PG8_SB(0, 1), b2 + hstep, voffB);
            PG8_WAIT_V(6); PG8_BAR; PG8_MMA(1, 1, At, B1); PG8_BAR;
            PG8_LDB(B0, 1, 0); PG8_SCHED; PG8_LDA(At, 1, 0); PG8_STAGE(PG8_SA(0, 1), a2 + hstep, voffA);
            PG8_WAIT_L(8); PG8_BAR; PG8_WAIT_L(0); PG8_MMA(0, 0, At, B0); PG8_BAR; PG8_SCHED;
            PG8_LDB(B1, 1, 1); PG8_STAGE(PG8_SB(1, 0), b3, voffB);
            PG8_BAR; PG8_WAIT_L(0); PG8_MMA(0, 1, At, B1); PG8_BAR;
            PG8_LDA(At, 1, 1); PG8_STAGE(PG8_SA(1, 0), a3, voffA);
            PG8_BAR; PG8_WAIT_L(0); PG8_MMA(1, 0, At, B0); PG8_BAR; PG8_SCHED;
            PG8_STAGE(PG8_SB(1, 1), b3 + hstep, voffB);
            PG8_WAIT_V(6); PG8_BAR; PG8_MMA(1, 1, At, B1); PG8_BAR;
            }
        }
        if constexpr (ALIGN_EPI) { if (wr == 0) PG8_BAR; }
        if constexpr (!Epi::AFTER_DRAIN) { E(acc, cur, wr, wc, fr, fq); S.done(cur); }
        if (!has_next) break;
#pragma unroll
        for (int a = 0; a < 2; ++a)
#pragma unroll
            for (int b = 0; b < 2; ++b)
#pragma unroll
                for (int m = 0; m < 4; ++m)
#pragma unroll
                    for (int n = 0; n < 2; ++n) acc[a][b][m][n] = (f32x4){0.f, 0.f, 0.f, 0.f};
        cur = nxt; cA = nA; cB = nB; ++ui;
        if constexpr (ALIGN_EPI) { if (wr == 1) PG8_BAR; }
    }
    PG8_WAIT_V(0);
    if constexpr (!ALIGN_EPI) { if (wr == 0) PG8_BAR; }
    PG8_BAR;
    if constexpr (Epi::AFTER_DRAIN) { E.fused(acc, cur, wr, wc, fr, fq, lds, wid, lane); S.done(cur); }
#undef PG8_SA
#undef PG8_SB
#undef PG8_STAGE
#undef PG8_LDA
#undef PG8_LDB
#undef PG8_MMA
#undef PG8_WAIT_V
#undef PG8_WAIT_L
#undef PG8_BAR
#undef PG8_SCHED
}
}

constexpr int BATCH = 8, T = 2048, D = 1024, M = BATCH * T, FF = 2816, NA = 6400, NB = 4096, NHM = 4, NHF = 16;
constexpr int NWAVES = 8;
constexpr float C2 = 0.125f * 1.4426950408889634f;
constexpr size_t MiB = 1u << 20;
constexpr size_t WS_CTL = 0, CTL_ZERO_BYTES = 1 * MiB;
constexpr size_t CTL_SS = 65536;
constexpr size_t CTL_STATS = 512 * 1024;
constexpr size_t WS_BIASA = 1 * MiB, WS_BIASB = 1 * MiB + 65536;
constexpr size_t WS_GATES = 2 * MiB;
constexpr size_t WS_CUM = 4 * MiB;
constexpr size_t WS_XB = 8 * MiB;
constexpr size_t WS_P = 40 * MiB, SLOT = 32 * MiB;
constexpr size_t WS_H1 = 40 * MiB, WS_W1GU = 128 * MiB, WS_W1D = 140 * MiB;
constexpr size_t WS_WINA = 232 * MiB, WS_WINB = 245 * MiB;
constexpr size_t WS_Y = 40 * MiB;
constexpr size_t WS_WOUT = 72 * MiB, WS_W2GU = 74 * MiB, WS_W2D = 86 * MiB;
constexpr size_t WS_H2 = 104 * MiB;
constexpr size_t WS_END = 256 * MiB;
static_assert(WS_H1 + (size_t)M * FF * 2 <= WS_W1GU && WS_W1GU + (size_t)2 * FF * D * 2 <= WS_W1D && WS_W1D + (size_t)D * FF * 2 <= WS_WINA, "map1");
static_assert(WS_WINA + (size_t)NA * D * 2 <= WS_WINB && WS_WINB + (size_t)NB * D * 2 <= WS_END, "map2");
static_assert(WS_W2GU + (size_t)2 * FF * D * 2 <= WS_W2D && WS_W2D + (size_t)D * FF * 2 <= WS_H2 && WS_H2 + (size_t)M * FF * 2 <= WS_WINA, "map3");

constexpr int RING_BYTES = 131072, LDS_BYTES = 147456;

#define GAS __attribute__((address_space(1)))
#define LAS __attribute__((address_space(3)))
typedef unsigned short bf16;
typedef unsigned v4u __attribute__((ext_vector_type(4)));
typedef unsigned v2u __attribute__((ext_vector_type(2)));
typedef float f32x4 __attribute__((ext_vector_type(4)));
__device__ __forceinline__ unsigned f2bf(float f) { unsigned u = __builtin_bit_cast(unsigned, f); return (u + 0x7fffu + ((u >> 16) & 1u)) >> 16; }
__device__ __forceinline__ unsigned pk2(float lo, float hi) { return f2bf(lo) | (f2bf(hi) << 16); }
__device__ __forceinline__ float bf2f(bf16 v) { return __uint_as_float((unsigned)v << 16); }
__device__ __forceinline__ float wave_sum(float v) {
#pragma unroll
    for (int o = 1; o < 64; o <<= 1) v += __shfl_xor(v, o);
    return v;
}
__device__ __forceinline__ float log_sigmoid(float x) { return fminf(x, 0.f) - log1pf(expf(-fabsf(x))); }

struct Args { const float* in[17]; float* out; unsigned char* ws; int ph_lo, ph_hi, coop, pad; };

struct MatDesc { const float* s0; const float* s1; const float* scale; bf16* dst; int K, Nsrc, nrows, kind; };
__device__ __forceinline__ int inA_src(int c) {
    if (c < 6144) { const int slot = c >> 10, j = c & 1023; const int st = slot == 0 ? 0 : slot == 1 ? 1024 : slot == 2 ? 2048 : slot == 3 ? 4104 : slot == 4 ? 5128 : 6152; return st + j; }
    const int g = c - 6144; if (g < 4) return 4096 + g; if (g < 8) return 4100 + (g - 4); if (g < 24) return 7176 + (g - 8); return -1;
}
__device__ __forceinline__ int inB_src(int c) {
    const int pn = c >> 8, ct = c & 255, bj = ct >> 7, wc = (ct >> 5) & 3, fq = (ct >> 3) & 3, n = (ct >> 2) & 1, i = ct & 3, j = 64 * pn + 16 * wc + 4 * fq + i;
    if (bj == 0) return n == 0 ? 3072 + j : 7192 + j;
    return n == 0 ? 8216 + j : -1;
}
__device__ __forceinline__ const float* src_col(const MatDesc& d, int c) {
    if (d.kind == 0) { const int pn = c >> 8, bj = (c >> 7) & 1, r = c & 127; const long long dl = (long long)((const char*)d.s1 - (const char*)d.s0) * bj; return (const float*)((const char*)d.s0 + dl) + 128 * pn + r; }
    if (d.kind == 1) return d.s0 + c;
    const int s = d.kind == 2 ? inA_src(c) : inB_src(c); return s < 0 ? nullptr : d.s0 + s;
}
__device__ __forceinline__ void transpose_item(const MatDesc& d, LAS float* scr, int item, int lane) {
    const int nblk = d.nrows / 32, kb = item / nblk, nb = item % nblk, k0 = 64 * kb, n0 = 32 * nb;
    const float* sp = src_col(d, n0 + (lane & 31));
#pragma unroll 8
    for (int i = 0; i < 32; ++i) { const int kk = 2 * i + (lane >> 5); float v = 0.f; if (sp) { v = sp[(size_t)(k0 + kk) * d.Nsrc]; if (d.scale) v *= d.scale[k0 + kk]; } scr[kk * 33 + (lane & 31)] = v; }
    asm volatile("s_waitcnt lgkmcnt(0)" ::: "memory");
    const int c = lane & 7;
#pragma unroll
    for (int j = 0; j < 4; ++j) { const int n = (lane >> 3) + 8 * j; const LAS float* s = scr + (8 * c) * 33 + n;
        v4u o; o.x = pk2(s[0 * 33], s[1 * 33]); o.y = pk2(s[2 * 33], s[3 * 33]); o.z = pk2(s[4 * 33], s[5 * 33]); o.w = pk2(s[6 * 33], s[7 * 33]);
        *(GAS v4u*)(d.dst + (size_t)(n0 + n) * d.K + k0 + 8 * c) = o; }
    asm volatile("s_waitcnt lgkmcnt(0)" ::: "memory");
}
__device__ __forceinline__ void convert_mat(const MatDesc d, LAS unsigned char* lds, int gw, int NGW, int wave, int lane) {
    LAS float* scr = (LAS float*)(lds + wave * 16384); const int nitems = (d.K / 64) * (d.nrows / 32);
#pragma unroll 1
    for (int it = gw; it < nitems; it += NGW) transpose_item(d, scr, it, lane);
}

__global__ __launch_bounds__(256) void fox_cumsum(const float* gates, float* cum) {
    __shared__ float part[256];
    const int bh = blockIdx.x, b = bh >> 4, h = bh & 15, tid = threadIdx.x;
    float v[8]; float s = 0.f;
#pragma unroll
    for (int i = 0; i < 8; ++i) { const int t = tid * 8 + i; v[i] = log_sigmoid(gates[((size_t)b * T + t) * 32 + 8 + h]); s += v[i]; v[i] = s; }
    part[tid] = s; __syncthreads();
    if (tid == 0) { float a = 0.f; for (int i = 0; i < 256; ++i) { const float x = part[i]; part[i] = a; a += x; } }
    __syncthreads();
    const float off = part[tid];
#pragma unroll
    for (int i = 0; i < 8; ++i) cum[(size_t)bh * T + tid * 8 + i] = v[i] + off;
}
__global__ __launch_bounds__(256) void fox_simple(const bf16* Q, const bf16* K, const bf16* V, bf16* O, const float* cum) {
    __shared__ float sc[4][T];
    const int wave = threadIdx.x >> 6, lane = threadIdx.x & 63;
    const int gwv = blockIdx.x * 4 + wave, h = gwv & 15, row = gwv >> 4, b = row / T, t = row % T;
    const float* c = cum + ((size_t)b * 16 + h) * T;
    float q[64];
    { const v4u* qp = (const v4u*)(Q + (size_t)row * D + h * 64);
#pragma unroll
      for (int i = 0; i < 8; ++i) { const v4u w = qp[i]; q[8 * i] = pg8::bf_lo(w.x); q[8 * i + 1] = pg8::bf_hi(w.x); q[8 * i + 2] = pg8::bf_lo(w.y); q[8 * i + 3] = pg8::bf_hi(w.y); q[8 * i + 4] = pg8::bf_lo(w.z); q[8 * i + 5] = pg8::bf_hi(w.z); q[8 * i + 6] = pg8::bf_lo(w.w); q[8 * i + 7] = pg8::bf_hi(w.w); } }
    const float ct = c[t]; float mx = -INFINITY;
    for (int s = lane; s <= t; s += 64) { const v4u* kp = (const v4u*)(K + ((size_t)b * T + s) * D + h * 64); float dot = 0.f;
#pragma unroll
        for (int i = 0; i < 8; ++i) { const v4u w = kp[i]; dot += q[8 * i] * pg8::bf_lo(w.x) + q[8 * i + 1] * pg8::bf_hi(w.x) + q[8 * i + 2] * pg8::bf_lo(w.y) + q[8 * i + 3] * pg8::bf_hi(w.y) + q[8 * i + 4] * pg8::bf_lo(w.z) + q[8 * i + 5] * pg8::bf_hi(w.z) + q[8 * i + 6] * pg8::bf_lo(w.w) + q[8 * i + 7] * pg8::bf_hi(w.w); }
        const float lg = dot + (ct - c[s]) * 1.4426950408889634f; sc[wave][s] = lg; mx = fmaxf(mx, lg); }
#pragma unroll
    for (int o = 1; o < 64; o <<= 1) mx = fmaxf(mx, __shfl_xor(mx, o));
    float sum = 0.f;
    for (int s = lane; s <= t; s += 64) { const float p = exp2f(sc[wave][s] - mx); sc[wave][s] = p; sum += p; }
    sum = wave_sum(sum);
    __syncthreads();
    float acc = 0.f; const bf16* vp = V + (size_t)b * T * D + h * 64 + lane;
    for (int s = 0; s <= t; ++s) acc += sc[wave][s] * bf2f(vp[(size_t)s * D]);
    O[(size_t)row * D + h * 64 + lane] = (bf16)f2bf(acc / sum);
}
__global__ __launch_bounds__(256) void mlstm_simple(const bf16* Pq, const bf16* Pk, bf16* Pv, const float* gates, const float* conv_w, const float* conv_b, float* stats) {
    __shared__ float red[4][20];
    const int blk = blockIdx.x, vs = blk & 15, h = (blk >> 4) & 3, b = blk >> 6, d = threadIdx.x, wave = d >> 6, lane = d & 63;
    const int cq = h * 256 + d, ck = 1024 + h * 256 + d;
    const float wq0 = conv_w[cq], wq1 = conv_w[2048 + cq], wq2 = conv_w[4096 + cq], wq3 = conv_w[6144 + cq], bq = conv_b[cq];
    const float wk0 = conv_w[ck], wk1 = conv_w[2048 + ck], wk2 = conv_w[4096 + ck], wk3 = conv_w[6144 + ck], bk = conv_b[ck];
    float C[16]; float n = 0.f, mst = 0.f;
#pragma unroll
    for (int i = 0; i < 16; ++i) C[i] = 0.f;
    float uq0 = 0.f, uq1 = 0.f, uq2 = 0.f, uk0 = 0.f, uk1 = 0.f, uk2 = 0.f;
    for (int t = 0; t < T; ++t) {
        const size_t row = (size_t)b * T + t;
        const float uq3 = bf2f(Pq[row * D + h * 256 + d]), uk3 = bf2f(Pk[row * D + h * 256 + d]);
        float qv = bq + wq0 * uq0 + wq1 * uq1 + wq2 * uq2 + wq3 * uq3, kv = bk + wk0 * uk0 + wk1 * uk1 + wk2 * uk2 + wk3 * uk3;
        qv = qv / (1.f + expf(-qv)); kv = kv / (1.f + expf(-kv)) * 0.0625f;
        uq0 = uq1; uq1 = uq2; uq2 = uq3; uk0 = uk1; uk1 = uk2; uk2 = uk3;
        const float li = gates[row * 32 + h], lf = log_sigmoid(gates[row * 32 + 4 + h]);
        const float mn = fmaxf(lf + mst, li), a = expf(lf + mst - mn), bc = expf(li - mn); mst = mn;
        const v4u* vp = (const v4u*)(Pv + row * D + h * 256 + vs * 16); const v4u v0 = vp[0], v1 = vp[1];
        const float vv[16] = {pg8::bf_lo(v0.x), pg8::bf_hi(v0.x), pg8::bf_lo(v0.y), pg8::bf_hi(v0.y), pg8::bf_lo(v0.z), pg8::bf_hi(v0.z), pg8::bf_lo(v0.w), pg8::bf_hi(v0.w),
                              pg8::bf_lo(v1.x), pg8::bf_hi(v1.x), pg8::bf_lo(v1.y), pg8::bf_hi(v1.y), pg8::bf_lo(v1.z), pg8::bf_hi(v1.z), pg8::bf_lo(v1.w), pg8::bf_hi(v1.w)};
        n = a * n + bc * kv;
        float part[17];
#pragma unroll
        for (int i = 0; i < 16; ++i) { C[i] = a * C[i] + bc * vv[i] * kv; part[i] = wave_sum(C[i] * qv); }
        part[16] = wave_sum(n * qv);
        __syncthreads();
        if (lane == 0) {
#pragma unroll
            for (int i = 0; i < 17; ++i) red[wave][i] = part[i]; }
        __syncthreads();
        if (d < 16) { const float den = red[0][16] + red[1][16] + red[2][16] + red[3][16];
            const float num = red[0][d] + red[1][d] + red[2][d] + red[3][d];
            const float hv = num / fmaxf(fabsf(den), expf(-mn));
            Pv[row * D + h * 256 + vs * 16 + d] = (bf16)f2bf(hv);
            float s1 = hv, s2 = hv * hv;
#pragma unroll
            for (int o = 1; o < 16; o <<= 1) { s1 += __shfl_xor(s1, o); s2 += __shfl_xor(s2, o); }
            if (d == 0) { unsafeAtomicAdd(stats + (row * 4 + h) * 2, s1); unsafeAtomicAdd(stats + (row * 4 + h) * 2 + 1, s2); } }
    }
}

__global__ void __launch_bounds__(NWAVES * 64, 2) mk_fwd(Args args) {
    extern __shared__ __attribute__((aligned(16))) unsigned char lds_raw[];
    LAS unsigned char* lds = (LAS unsigned char*)lds_raw;
    const int tid = threadIdx.x, lane = tid & 63, wave = __builtin_amdgcn_readfirstlane(tid >> 6);
    const int G = gridDim.x, gw = blockIdx.x * NWAVES + wave, NGW = G * NWAVES;
    unsigned char* ws = args.ws;
    float* ctlf = (float*)(ws + WS_CTL);
    float* SS0 = (float*)(ws + CTL_SS * 1); float* SS1 = (float*)(ws + CTL_SS * 2); float* SS2 = (float*)(ws + CTL_SS * 3); float* SS3 = (float*)(ws + CTL_SS * 4);
    float* STATS = (float*)(ws + CTL_STATS);
    float* BIASA = (float*)(ws + WS_BIASA); float* BIASB = (float*)(ws + WS_BIASB); float* GATES = (float*)(ws + WS_GATES);
    bf16* XB = (bf16*)(ws + WS_XB); bf16* P = (bf16*)(ws + WS_P);
    const int lo = args.ph_lo, hi = args.ph_hi;
#define IN(k) (lo <= (k) && (k) < hi)
#define SEAM(k) do { if (IN(k) && IN((k) + 1)) { cooperative_groups::this_grid().sync(); } } while (0)
    (void)ctlf;
    if (IN(0)) {
        convert_mat(MatDesc{args.in[2], args.in[3], args.in[1], (bf16*)(ws + WS_W1GU), D, FF, 2 * FF, 0}, lds, gw, NGW, wave, lane);
        convert_mat(MatDesc{args.in[4], nullptr, nullptr, (bf16*)(ws + WS_W1D), FF, D, D, 1}, lds, gw, NGW, wave, lane);
        convert_mat(MatDesc{args.in[6], nullptr, args.in[5], (bf16*)(ws + WS_WINA), D, 9240, NA, 2}, lds, gw, NGW, wave, lane);
        convert_mat(MatDesc{args.in[6], nullptr, args.in[5], (bf16*)(ws + WS_WINB), D, 9240, NB, 3}, lds, gw, NGW, wave, lane);
        for (int c = blockIdx.x * 512 + tid; c < NA + NB; c += G * 512) {
            if (c < NA) { const int s = inA_src(c); BIASA[c] = s < 0 ? 0.f : args.in[7][s]; } else { const int s = inB_src(c - NA); BIASB[c - NA] = s < 0 ? 0.f : args.in[7][s]; } }
        for (int m = gw; m < M; m += NGW) {
            const GAS f32x4* xr = (const GAS f32x4*)(args.in[0] + (size_t)m * D) + lane; GAS unsigned long long* o8 = (GAS unsigned long long*)(XB + (size_t)m * D) + lane; float s = 0.f;
#pragma unroll
            for (int j = 0; j < 4; ++j) { const f32x4 v = xr[64 * j]; s += (v.x * v.x + v.y * v.y) + (v.z * v.z + v.w * v.w); o8[64 * j] = (unsigned long long)pk2(v.x, v.y) | ((unsigned long long)pk2(v.z, v.w) << 32); }
            s = wave_sum(s); if (lane == 0) SS0[m] = s; }
    }
    SEAM(0);
    if (IN(1)) { pg8::Gemm g{XB, (const bf16*)(ws + WS_W1GU), M, 2 * FF, D}; pg8::StaticOrder S; S.init(M, 2 * FF, G, (int)blockIdx.x);
        pg8::EpiSwiGLU E{(bf16*)(ws + WS_H1), FF, SS0};
        pg8::gemm_phase<pg8::EpiSwiGLU, pg8::StaticOrder, true, true>(lds, g, S, E); }
    SEAM(1);
    if (IN(2)) { pg8::Gemm g{(const bf16*)(ws + WS_H1), (const bf16*)(ws + WS_W1D), M, D, FF}; pg8::StaticOrder S; S.init(M, D, G, (int)blockIdx.x);
        pg8::EpiResid E{args.in[0], args.out, XB, SS1, 0.5f};
        pg8::gemm_phase<pg8::EpiResid, pg8::StaticOrder, true, true>(lds, g, S, E); }
    SEAM(2);
    if (IN(3)) { pg8::Gemm g{XB, (const bf16*)(ws + WS_WINA), M, NA, D}; pg8::StaticOrder S; S.init(M, NA, G, (int)blockIdx.x);
        pg8::EpiInA E{P, (size_t)M * D, GATES, BIASA, SS1, C2};
        pg8::gemm_phase<pg8::EpiInA, pg8::StaticOrder, true, true>(lds, g, S, E); }
    SEAM(3);
    SEAM(4);
    if (IN(5)) {
        convert_mat(MatDesc{args.in[11], nullptr, nullptr, (bf16*)(ws + WS_WOUT), D, D, D, 1}, lds, gw, NGW, wave, lane);
        convert_mat(MatDesc{args.in[13], args.in[14], args.in[12], (bf16*)(ws + WS_W2GU), D, FF, 2 * FF, 0}, lds, gw, NGW, wave, lane);
        convert_mat(MatDesc{args.in[15], nullptr, nullptr, (bf16*)(ws + WS_W2D), FF, D, D, 1}, lds, gw, NGW, wave, lane);
        __syncthreads();
        pg8::Gemm g{XB, (const bf16*)(ws + WS_WINB), M, NB, D}; pg8::StaticOrder S; S.init(M, NB, G, (int)blockIdx.x);
        pg8::EpiInB E{P + 2 * (size_t)M * D, P + 3 * (size_t)M * D, STATS, args.in[10], BIASB, SS1, (bf16*)(ws + WS_Y)};
        pg8::gemm_phase<pg8::EpiInB, pg8::StaticOrder, true, true>(lds, g, S, E); }
    SEAM(5);
    if (IN(6)) { pg8::Gemm g{(const bf16*)(ws + WS_Y), (const bf16*)(ws + WS_WOUT), M, D, D}; pg8::StaticOrder S; S.init(M, D, G, (int)blockIdx.x);
        pg8::EpiResid E{args.out, args.out, XB, SS2, 1.0f};
        pg8::gemm_phase<pg8::EpiResid, pg8::StaticOrder, true, true>(lds, g, S, E); }
    SEAM(6);
    if (IN(7)) { pg8::Gemm g{XB, (const bf16*)(ws + WS_W2GU), M, 2 * FF, D}; pg8::StaticOrder S; S.init(M, 2 * FF, G, (int)blockIdx.x);
        pg8::EpiSwiGLU E{(bf16*)(ws + WS_H2), FF, SS2};
        pg8::gemm_phase<pg8::EpiSwiGLU, pg8::StaticOrder, true, true>(lds, g, S, E); }
    SEAM(7);
    if (IN(8)) { pg8::Gemm g{(const bf16*)(ws + WS_H2), (const bf16*)(ws + WS_W2D), M, D, FF}; pg8::StaticOrder S; S.init(M, D, G, (int)blockIdx.x);
        pg8::EpiResid E{args.out, args.out, nullptr, SS3, 0.5f};
        pg8::gemm_phase<pg8::EpiResid, pg8::StaticOrder, true, true>(lds, g, S, E); }
    SEAM(8);
    if (IN(9)) {
        for (int m = gw; m < M; m += NGW) { GAS f32x4* xr = (GAS f32x4*)(args.out + (size_t)m * D) + lane; const GAS f32x4* gr = (const GAS f32x4*)args.in[16] + lane;
            const float rs = __builtin_amdgcn_rsqf(SS3[m] * (1.f / D) + 1e-6f);
#pragma unroll
            for (int j = 0; j < 4; ++j) { const f32x4 v = xr[64 * j], gv = gr[64 * j]; xr[64 * j] = v * rs * gv; } }
    }
#undef IN
#undef SEAM
}

extern "C" void kernel_launch(void* const* d_in, const int* in_sizes, int n_in, void* d_out, int out_size, void* d_ws, size_t ws_size, hipStream_t stream) {
    static int ready = 0;
    if (!ready) { if (hipFuncSetAttribute((const void*)mk_fwd, hipFuncAttributeMaxDynamicSharedMemorySize, LDS_BYTES) != hipSuccess) { fprintf(stderr, "hipFuncSetAttribute failed\n"); } ready = 1; }
    if (n_in != 17 || ws_size < WS_END) { fprintf(stderr, "kernel_launch: unexpected n_in %d / ws %zu\n", n_in, ws_size); return; }
    (void)hipMemsetAsync((char*)d_ws + WS_CTL, 0, CTL_ZERO_BYTES, stream);
    Args a{};
    for (int i = 0; i < 17; ++i) a.in[i] = (const float*)d_in[i];
    a.out = (float*)d_out; a.ws = (unsigned char*)d_ws; a.coop = 0;
    unsigned char* ws = (unsigned char*)d_ws;
    for (int ph = 0; ph <= 3; ++ph) { a.ph_lo = ph; a.ph_hi = ph + 1; hipLaunchKernelGGL(mk_fwd, dim3(256), dim3(NWAVES * 64), LDS_BYTES, stream, a); }
    bf16* P = (bf16*)(ws + WS_P); const size_t S = (size_t)M * D;
    hipLaunchKernelGGL(fox_cumsum, dim3(BATCH * 16), dim3(256), 0, stream, (const float*)(ws + WS_GATES), (float*)(ws + WS_CUM));
    hipLaunchKernelGGL(fox_simple, dim3(M * 16 / 4), dim3(256), 0, stream, (const bf16*)(P + 3 * S), (const bf16*)(P + 4 * S), (const bf16*)(P + 5 * S), P + 3 * S, (const float*)(ws + WS_CUM));
    hipLaunchKernelGGL(mlstm_simple, dim3(BATCH * 4 * 16), dim3(256), 0, stream, (const bf16*)P, (const bf16*)(P + S), P + 2 * S, (const float*)(ws + WS_GATES), (const float*)d_in[8], (const float*)d_in[9], (float*)(ws + CTL_STATS));
    for (int ph = 5; ph <= 9; ++ph) { a.ph_lo = ph; a.ph_hi = ph + 1; hipLaunchKernelGGL(mk_fwd, dim3(256), dim3(NWAVES * 64), LDS_BYTES, stream, a); }
}
```

```cpp
#include <hip/hip_runtime.h>
#include <hip/hip_cooperative_groups.h>
#include <hip/hip_bf16.h>
#include <cstdio>
#include <cstdint>
#include <cmath>
namespace pg8 {
#define PG8_LAS __attribute__((address_space(3)))
typedef unsigned short bf16_t;
typedef short bf16x8 __attribute__((ext_vector_type(8)));
typedef float f32x4 __attribute__((ext_vector_type(4)));
typedef unsigned u32x4 __attribute__((ext_vector_type(4)));
constexpr int BM = 256, BK = 64, HALF = 128, HTB = HALF * BK * 2  , STAGE_BYTES = 8 * HTB, NXCD = 8, WGM = 8;

__host__ __device__ __forceinline__ int lds_byte(int r, int c) { const int st = (r >> 4) * 2 + (c >> 5), rr = r & 15, cc = c & 31, ob = rr * 64 + cc * 2; return st * 1024 + (ob ^ (((ob >> 9) & 1) << 5)); }
__host__ __device__ __forceinline__ void stage_rc(int b, int& R, int& C) { const int st = b / 1024, sb = b % 1024, swz = sb ^ (((sb >> 9) & 1) << 5); R = (st >> 1) * 16 + swz / 64; C = (st & 1) * 32 + (swz % 64) / 2; }
__host__ __device__ __forceinline__ int perm32(int rho) { const int n = rho >> 4, i = rho & 15; return 8 * (i >> 2) + 4 * n + (i & 3); }

struct Unit { int pm, pn; };
struct Gemm { const bf16_t* A; const bf16_t* Bt; int M, N, K; };

struct StaticOrder {
    int nM, nN, nwg, G, c;
    __host__ __device__ void init(int M, int N, int G_, int c_) { nM = M / BM; nN = N / BM; nwg = nM * nN; G = G_; c = c_; }
    __host__ __device__ bool next(int i, Unit& u) const {
        const long L = (long)i * G + c; if (L >= nwg) return false;
        int wgid = (int)L; { const int q = nwg / NXCD, r = nwg % NXCD, xcd = wgid % NXCD, off = wgid / NXCD; wgid = (xcd < r ? xcd * (q + 1) : r * (q + 1) + (xcd - r) * q) + off; }
        const int nig = WGM * nN, gid = wgid / nig, fm = gid * WGM, gsz = (nM - fm) < WGM ? (nM - fm) : WGM;
        u.pm = fm + ((wgid % nig) % gsz); u.pn = (wgid % nig) / gsz; return true;
    }
    __device__ __forceinline__ void a_ready(const Unit&) const {}
    __device__ __forceinline__ void done(const Unit&) const {}
};

__device__ __forceinline__ unsigned cvt_pk_bf16(float lo, float hi) { unsigned r; asm volatile("v_cvt_pk_bf16_f32 %0, %1, %2" : "=v"(r) : "v"(lo), "v"(hi)); return r; }
typedef float f32x2 __attribute__((ext_vector_type(2)));
typedef unsigned u32x2 __attribute__((ext_vector_type(2)));
constexpr float RMS_EPS = 1e-6f, INV_D = 1.0f / 1024.0f, LOG2E = 1.4426950408889634f;
__device__ __forceinline__ float sigm(float x) { return __builtin_amdgcn_rcpf(1.f + __builtin_amdgcn_exp2f(-LOG2E * x)); }
__device__ __forceinline__ float bf_lo(unsigned w) { return __uint_as_float(w << 16); }
__device__ __forceinline__ float bf_hi(unsigned w) { return __uint_as_float(w & 0xffff0000u); }

struct EpiSwiGLU {
    static constexpr bool PERM = true, AFTER_DRAIN = false;
    bf16_t* H; int ldh; const float* ss;
    __device__ __forceinline__ void operator()(const f32x4 (&acc)[2][2][4][2], const Unit& u, int wr, int wc, int fr, int fq) const {
        const int row0 = u.pm * BM + wr * 64 + fr, col0 = u.pn * 128 + wc * 32 + 8 * fq;
        float rsv[2][4];
#pragma unroll
        for (int ai = 0; ai < 2; ++ai)
#pragma unroll
            for (int m = 0; m < 4; ++m) rsv[ai][m] = ss[row0 + ai * HALF + m * 16];
#pragma unroll
        for (int ai = 0; ai < 2; ++ai)
#pragma unroll
            for (int m = 0; m < 4; ++m) { const int row = row0 + ai * HALF + m * 16; const float rs = __builtin_amdgcn_rsqf(rsv[ai][m] * INV_D + RMS_EPS);
                const f32x4 g0 = acc[ai][0][m][0] * rs, g1 = acc[ai][0][m][1] * rs, p0 = acc[ai][1][m][0] * rs, p1 = acc[ai][1][m][1] * rs;
                u32x4 w;
                w.x = cvt_pk_bf16(g0[0] * sigm(g0[0]) * p0[0], g0[1] * sigm(g0[1]) * p0[1]); w.y = cvt_pk_bf16(g0[2] * sigm(g0[2]) * p0[2], g0[3] * sigm(g0[3]) * p0[3]);
                w.z = cvt_pk_bf16(g1[0] * sigm(g1[0]) * p1[0], g1[1] * sigm(g1[1]) * p1[1]); w.w = cvt_pk_bf16(g1[2] * sigm(g1[2]) * p1[2], g1[3] * sigm(g1[3]) * p1[3]);
                *(u32x4*)(H + (size_t)row * ldh + col0) = w; }
    }
};

struct EpiResid {
    static constexpr bool PERM = true, AFTER_DRAIN = false;
    const float* base; float* out; bf16_t* xb; float* ssout; float alpha;
    __device__ __forceinline__ void operator()(const f32x4 (&acc)[2][2][4][2], const Unit& u, int wr, int wc, int fr, int fq) const {
        const int row0 = u.pm * BM + wr * 64 + fr, col0 = u.pn * BM + wc * 32 + 8 * fq;
#pragma unroll
        for (int ai = 0; ai < 2; ++ai) {
            f32x4 bs[4][2][2];
#pragma unroll
            for (int m = 0; m < 4; ++m)
#pragma unroll
                for (int bj = 0; bj < 2; ++bj) { const size_t off = (size_t)(row0 + ai * HALF + m * 16) * 1024 + col0 + bj * HALF; bs[m][bj][0] = *(const f32x4*)(base + off); bs[m][bj][1] = *(const f32x4*)(base + off + 4); }
#pragma unroll
            for (int m = 0; m < 4; ++m) { const int row = row0 + ai * HALF + m * 16; float q = 0.f;
#pragma unroll
                for (int bj = 0; bj < 2; ++bj) { const size_t off = (size_t)row * 1024 + col0 + bj * HALF;
                    const f32x4 o0 = bs[m][bj][0] + acc[ai][bj][m][0] * alpha, o1 = bs[m][bj][1] + acc[ai][bj][m][1] * alpha;
                    *(f32x4*)(out + off) = o0; *(f32x4*)(out + off + 4) = o1;
                    if (xb) { u32x4 w; w.x = cvt_pk_bf16(o0[0], o0[1]); w.y = cvt_pk_bf16(o0[2], o0[3]); w.z = cvt_pk_bf16(o1[0], o1[1]); w.w = cvt_pk_bf16(o1[2], o1[3]); *(u32x4*)(xb + off) = w; }
                    q += (o0[0] * o0[0] + o0[1] * o0[1]) + (o0[2] * o0[2] + o0[3] * o0[3]) + (o1[0] * o1[0] + o1[1] * o1[1]) + (o1[2] * o1[2] + o1[3] * o1[3]); }
                q += __shfl_xor(q, 16); q += __shfl_xor(q, 32);
                if (fq == 0) unsafeAtomicAdd(ssout + row, q); }
            asm volatile("" ::: "memory"); }
    }
};

struct EpiResidNorm {
    static constexpr bool PERM = true, AFTER_DRAIN = false;
    const float* base; float* out; float* ss; unsigned* cnt; const float* gain; float alpha;
    __device__ __forceinline__ void operator()(const f32x4 (&acc_c)[2][2][4][2], const Unit& u, int wr, int wc, int fr, int fq) const {
        f32x4 (&acc)[2][2][4][2] = const_cast<f32x4 (&)[2][2][4][2]>(acc_c);
        const int row0 = u.pm * BM + wr * 64 + fr, col0 = u.pn * BM + wc * 32 + 8 * fq;
#pragma unroll
        for (int ai = 0; ai < 2; ++ai) {
            f32x4 bs[4][2][2];
#pragma unroll
            for (int m = 0; m < 4; ++m)
#pragma unroll
                for (int bj = 0; bj < 2; ++bj) { const size_t off = (size_t)(row0 + ai * HALF + m * 16) * 1024 + col0 + bj * HALF; bs[m][bj][0] = *(const f32x4*)(base + off); bs[m][bj][1] = *(const f32x4*)(base + off + 4); }
#pragma unroll
            for (int m = 0; m < 4; ++m) { const int row = row0 + ai * HALF + m * 16; float q = 0.f;
#pragma unroll
                for (int bj = 0; bj < 2; ++bj) { const f32x4 o0 = bs[m][bj][0] + acc[ai][bj][m][0] * alpha, o1 = bs[m][bj][1] + acc[ai][bj][m][1] * alpha;
                    acc[ai][bj][m][0] = o0; acc[ai][bj][m][1] = o1;
                    q += (o0[0] * o0[0] + o0[1] * o0[1]) + (o0[2] * o0[2] + o0[3] * o0[3]) + (o1[0] * o1[0] + o1[1] * o1[1]) + (o1[2] * o1[2] + o1[3] * o1[3]); }
                q += __shfl_xor(q, 16); q += __shfl_xor(q, 32);
                if (fq == 0) __hip_atomic_fetch_add(ss + row, q, __ATOMIC_RELAXED, __HIP_MEMORY_SCOPE_AGENT); }
            asm volatile("" ::: "memory"); }
        asm volatile("s_waitcnt vmcnt(0)" ::: "memory");
        __builtin_amdgcn_fence(__ATOMIC_RELEASE, "agent");
        unsigned* c = cnt + 64 * u.pm;
        if (__builtin_amdgcn_readfirstlane((int)(threadIdx.x & 63)) == 0 || true) { if ((threadIdx.x & 63) == 0) __hip_atomic_fetch_add(c, 1u, __ATOMIC_RELAXED, __HIP_MEMORY_SCOPE_AGENT); }
        for (unsigned spin = 0; spin < (1u << 22); ++spin) { if (__hip_atomic_load(c, __ATOMIC_RELAXED, __HIP_MEMORY_SCOPE_AGENT) >= 32u) break; __builtin_amdgcn_s_sleep(2); }
        __builtin_amdgcn_fence(__ATOMIC_ACQUIRE, "agent");
        f32x4 gv[2][2];
#pragma unroll
        for (int bj = 0; bj < 2; ++bj) { gv[bj][0] = *(const f32x4*)(gain + col0 + bj * HALF); gv[bj][1] = *(const f32x4*)(gain + col0 + bj * HALF + 4); }
#pragma unroll
        for (int ai = 0; ai < 2; ++ai)
#pragma unroll
            for (int m = 0; m < 4; ++m) { const int row = row0 + ai * HALF + m * 16;
                const float rs = __builtin_amdgcn_rsqf(__hip_atomic_load(ss + row, __ATOMIC_RELAXED, __HIP_MEMORY_SCOPE_AGENT) * INV_D + RMS_EPS);
#pragma unroll
                for (int bj = 0; bj < 2; ++bj) { const size_t off = (size_t)row * 1024 + col0 + bj * HALF;
                    *(f32x4*)(out + off) = acc[ai][bj][m][0] * rs * gv[bj][0]; *(f32x4*)(out + off + 4) = acc[ai][bj][m][1] * rs * gv[bj][1]; } }
    }
};

struct EpiInA {
    static constexpr bool PERM = true, AFTER_DRAIN = false;
    bf16_t* P; size_t slot_stride; float* gates; const float* bias; const float* ss; float qscale;
    __device__ __forceinline__ void operator()(const f32x4 (&acc)[2][2][4][2], const Unit& u, int wr, int wc, int fr, int fq) const {
        const int row0 = u.pm * BM + wr * 64 + fr, colt = u.pn * BM;
        if (colt >= 6144) {
            if (wc == 0) { const f32x4 bv0 = *(const f32x4*)(bias + colt + 8 * fq), bv1 = *(const f32x4*)(bias + colt + 8 * fq + 4);
#pragma unroll
                for (int ai = 0; ai < 2; ++ai)
#pragma unroll
                    for (int m = 0; m < 4; ++m) { const int row = row0 + ai * HALF + m * 16; const float rs = __builtin_amdgcn_rsqf(ss[row] * INV_D + RMS_EPS);
                        *(f32x4*)(gates + (size_t)row * 32 + 8 * fq) = acc[ai][0][m][0] * rs + bv0; *(f32x4*)(gates + (size_t)row * 32 + 8 * fq + 4) = acc[ai][0][m][1] * rs + bv1; } }
            return; }
        const int slot = colt >> 10, cb = (colt & 1023) + wc * 32 + 8 * fq; const float sc = (slot == 3) ? qscale : 1.f;
        bf16_t* O = P + (size_t)slot * slot_stride;
        f32x4 bv[2][2];
#pragma unroll
        for (int bj = 0; bj < 2; ++bj)
#pragma unroll
            for (int n = 0; n < 2; ++n) bv[bj][n] = *(const f32x4*)(bias + colt + bj * HALF + wc * 32 + 8 * fq + 4 * n);
        float rsv[2][4];
#pragma unroll
        for (int ai = 0; ai < 2; ++ai)
#pragma unroll
            for (int m = 0; m < 4; ++m) rsv[ai][m] = ss[row0 + ai * HALF + m * 16];
#pragma unroll
        for (int ai = 0; ai < 2; ++ai)
#pragma unroll
            for (int m = 0; m < 4; ++m) { const int row = row0 + ai * HALF + m * 16; const float rs = __builtin_amdgcn_rsqf(rsv[ai][m] * INV_D + RMS_EPS);
#pragma unroll
                for (int bj = 0; bj < 2; ++bj) { const f32x4 v0 = (acc[ai][bj][m][0] * rs + bv[bj][0]) * sc, v1 = (acc[ai][bj][m][1] * rs + bv[bj][1]) * sc;
                    u32x4 w; w.x = cvt_pk_bf16(v0[0], v0[1]); w.y = cvt_pk_bf16(v0[2], v0[3]); w.z = cvt_pk_bf16(v1[0], v1[1]); w.w = cvt_pk_bf16(v1[2], v1[3]);
                    *(u32x4*)(O + (size_t)row * 1024 + cb + bj * HALF) = w; } }
    }
};

struct EpiInB {
    static constexpr bool PERM = true, AFTER_DRAIN = false;
    const bf16_t* ha; const bf16_t* yb; const float* stats; const float* gn; const float* bias; const float* ss; bf16_t* Y;
    __device__ __forceinline__ void operator()(const f32x4 (&acc)[2][2][4][2], const Unit& u, int wr, int wc, int fr, int fq) const {
        const int row0 = u.pm * BM + wr * 64 + fr, j = u.pn * 64 + wc * 16 + 4 * fq, head = j >> 8, cb = u.pn * BM + wc * 32 + 8 * fq;
        const f32x4 bmo = *(const f32x4*)(bias + cb), bga = *(const f32x4*)(bias + cb + 4), bgb = *(const f32x4*)(bias + cb + HALF), gnv = *(const f32x4*)(gn + j);
        float rsv[2][4]; f32x2 stv[2][4]; u32x2 hwv[2][4], ywv[2][4];
#pragma unroll
        for (int ai = 0; ai < 2; ++ai)
#pragma unroll
            for (int m = 0; m < 4; ++m) { const int row = row0 + ai * HALF + m * 16; rsv[ai][m] = ss[row]; stv[ai][m] = *(const f32x2*)(stats + ((size_t)row * 4 + head) * 2);
                hwv[ai][m] = *(const u32x2*)(ha + (size_t)row * 1024 + j); ywv[ai][m] = *(const u32x2*)(yb + (size_t)row * 1024 + j); }
#pragma unroll
        for (int ai = 0; ai < 2; ++ai)
#pragma unroll
            for (int m = 0; m < 4; ++m) { const int row = row0 + ai * HALF + m * 16; const float rs = __builtin_amdgcn_rsqf(rsv[ai][m] * INV_D + RMS_EPS);
                const f32x4 mo = acc[ai][0][m][0] * rs + bmo, ga = acc[ai][0][m][1] * rs + bga, gb = acc[ai][1][m][0] * rs + bgb;
                const float s1 = stv[ai][m].x, s2 = stv[ai][m].y;
                const float mean = s1 * (1.f / 256.f), var = fmaxf(s2 * (1.f / 256.f) - mean * mean, 0.f), rln = __builtin_amdgcn_rsqf(var + RMS_EPS);
                const u32x2 hw = hwv[ai][m], yw = ywv[ai][m];
                const f32x4 hv = {bf_lo(hw.x), bf_hi(hw.x), bf_lo(hw.y), bf_hi(hw.y)}, yv = {bf_lo(yw.x), bf_hi(yw.x), bf_lo(yw.y), bf_hi(yw.y)};
                f32x4 y;
#pragma unroll
                for (int i = 0; i < 4; ++i) y[i] = sigm(ga[i]) * sigm(mo[i]) * ((hv[i] - mean) * rln * gnv[i]) + sigm(gb[i]) * yv[i];
                u32x2 w; w.x = cvt_pk_bf16(y[0], y[1]); w.y = cvt_pk_bf16(y[2], y[3]);
                *(u32x2*)(Y + (size_t)row * 1024 + j) = w; }
    }
};

template <class Epi, class Sched, bool ALIGN_EPI = false, bool SP2 = false>
__device__ __forceinline__ void gemm_phase(PG8_LAS unsigned char* lds, const Gemm g, const Sched& S, const Epi& E) {
    const int tid = threadIdx.x, wid = __builtin_amdgcn_readfirstlane(tid >> 6), lane = tid & 63, wr = wid >> 2, wc = wid & 3, fr = lane & 15, fq = lane >> 4;
    const int K = g.K, nt = K / BK;
    unsigned voffA[2], voffB[2];
#pragma unroll
    for (int i = 0; i < 2; ++i) { int R, C; stage_rc(tid * 16 + i * 8192, R, C); const int Rb = Epi::PERM ? ((R & ~31) + perm32(R & 31)) : R;
        voffA[i] = (unsigned)(R * K + C) * 2u; voffB[i] = (unsigned)(Rb * K + C) * 2u; }
    const size_t kstep = (size_t)(BK * 2);
    const size_t hstep = (size_t)HALF * K * 2;
    const size_t tstep = 2 * hstep;
    const unsigned ldsw = (unsigned)wid * 1024u;
    const int aoff = lds_byte(wr * 64 + fr, fq * 8), boff = lds_byte(wc * 32 + fr, fq * 8);
#define PG8_SA(b, h) (((b) * 2 + (h)) * HTB)
#define PG8_SB(b, h) ((4 + (b) * 2 + (h)) * HTB)
#define PG8_STAGE(bufoff, gbase, voff) do { _Pragma("unroll") for (int _i = 0; _i < 2; ++_i) \
        __builtin_amdgcn_global_load_lds((const unsigned*)((const char*)(gbase) + (voff)[_i]), (PG8_LAS unsigned*)(lds + (bufoff) + ldsw + _i * 8192), 16, 0, 0); } while (0)
#define PG8_LDA(dst, b, h) do { _Pragma("unroll") for (int m = 0; m < 4; ++m) _Pragma("unroll") for (int k = 0; k < 2; ++k) dst[m][k] = *(const PG8_LAS bf16x8*)(lds + PG8_SA(b, h) + aoff + m * 2048 + k * 1024); } while (0)
#define PG8_LDB(dst, b, h) do { _Pragma("unroll") for (int n = 0; n < 2; ++n) _Pragma("unroll") for (int k = 0; k < 2; ++k) dst[n][k] = *(const PG8_LAS bf16x8*)(lds + PG8_SB(b, h) + boff + n * 2048 + k * 1024); } while (0)
#define PG8_MMA(ai, bj, At, Bt) do { __builtin_amdgcn_s_setprio(1); _Pragma("unroll") for (int m = 0; m < 4; ++m) _Pragma("unroll") for (int n = 0; n < 2; ++n) _Pragma("unroll") for (int k = 0; k < 2; ++k) \
        acc[ai][bj][m][n] = __builtin_amdgcn_mfma_f32_16x16x32_bf16(Bt[n][k], At[m][k], acc[ai][bj][m][n], 0, 0, 0); __builtin_amdgcn_s_setprio(0); } while (0)
#define PG8_WAIT_V(n) asm volatile("s_waitcnt vmcnt(" #n ")" ::: "memory")
#define PG8_WAIT_L(n) asm volatile("s_waitcnt lgkmcnt(" #n ")" ::: "memory")
#define PG8_BAR __builtin_amdgcn_s_barrier()
#define PG8_SCHED __builtin_amdgcn_sched_barrier(0)
    Unit cur, nxt; int ui = 0;
    if (!S.next(0, cur)) return;
    f32x4 acc[2][2][4][2];
#pragma unroll
    for (int a = 0; a < 2; ++a)
#pragma unroll
        for (int b = 0; b < 2; ++b)
#pragma unroll
            for (int m = 0; m < 4; ++m)
#pragma unroll
                for (int n = 0; n < 2; ++n) acc[a][b][m][n] = (f32x4){0.f, 0.f, 0.f, 0.f};
    bf16x8 At[4][2], B0[2][2], B1[2][2];
    const char* cA = (const char*)g.A + (size_t)cur.pm * tstep; const char* cB = (const char*)g.Bt + (size_t)cur.pn * tstep;
    S.a_ready(cur);
    if constexpr (SP2) {
        PG8_STAGE(PG8_SB(0, 0), cB, voffB); PG8_STAGE(PG8_SB(0, 1), cB + hstep, voffB); PG8_STAGE(PG8_SA(0, 0), cA, voffA); PG8_STAGE(PG8_SA(0, 1), cA + hstep, voffA);
        if (wr == 1) PG8_BAR;
        PG8_WAIT_V(2); PG8_BAR;
        PG8_STAGE(PG8_SB(1, 0), cB + kstep, voffB); PG8_STAGE(PG8_SA(1, 0), cA + kstep, voffA); PG8_STAGE(PG8_SB(1, 1), cB + hstep + kstep, voffB);
        PG8_WAIT_V(6); PG8_BAR;
    } else {
        PG8_STAGE(PG8_SB(0, 0), cB, voffB); PG8_STAGE(PG8_SA(0, 0), cA, voffA); PG8_STAGE(PG8_SB(0, 1), cB + hstep, voffB); PG8_STAGE(PG8_SA(0, 1), cA + hstep, voffA);
        if (wr == 1) PG8_BAR;
        PG8_WAIT_V(4); PG8_BAR;
        PG8_STAGE(PG8_SB(1, 0), cB + kstep, voffB); PG8_STAGE(PG8_SA(1, 0), cA + kstep, voffA); PG8_STAGE(PG8_SB(1, 1), cB + hstep + kstep, voffB);
        PG8_WAIT_V(6); PG8_BAR;
    }
    for (;;) {
        const bool has_next = S.next(ui + 1, nxt);
        const char* nA = has_next ? (const char*)g.A + (size_t)nxt.pm * tstep : cA; const char* nB = has_next ? (const char*)g.Bt + (size_t)nxt.pn * tstep : cB;
        for (int t = 0; t < nt; t += 2) {
            const bool last = (t == nt - 2);
            const char* a1 = cA + (size_t)(t + 1) * kstep;
            const char* a2 = last ? nA : cA + (size_t)(t + 2) * kstep; const char* b2 = last ? nB : cB + (size_t)(t + 2) * kstep;
            const char* a3 = a2 + kstep; const char* b3 = b2 + kstep;
            if (last && has_next) S.a_ready(nxt);
            if constexpr (SP2) {
            PG8_LDB(B0, 0, 0); PG8_LDB(B1, 0, 1); PG8_SCHED; PG8_LDA(At, 0, 0); PG8_STAGE(PG8_SA(1, 1), a1 + hstep, voffA);
            PG8_WAIT_V(8); PG8_WAIT_L(0); PG8_BAR; PG8_MMA(0, 0, At, B0); PG8_MMA(0, 1, At, B1); PG8_BAR; PG8_SCHED;
            PG8_LDA(At, 0, 1); PG8_STAGE(PG8_SB(0, 0), b2, voffB); PG8_STAGE(PG8_SB(0, 1), b2 + hstep, voffB); PG8_STAGE(PG8_SA(0, 0), a2, voffA);
            PG8_WAIT_V(8); PG8_WAIT_L(0); PG8_BAR; PG8_MMA(1, 0, At, B0); PG8_MMA(1, 1, At, B1); PG8_BAR; PG8_SCHED;
            PG8_LDB(B0, 1, 0); PG8_LDB(B1, 1, 1); PG8_SCHED; PG8_LDA(At, 1, 0); PG8_STAGE(PG8_SA(0, 1), a2 + hstep, voffA);
            PG8_WAIT_V(8); PG8_WAIT_L(0); PG8_BAR; PG8_MMA(0, 0, At, B0); PG8_MMA(0, 1, At, B1); PG8_BAR; PG8_SCHED;
            PG8_LDA(At, 1, 1); PG8_STAGE(PG8_SB(1, 0), b3, voffB); PG8_STAGE(PG8_SB(1, 1), b3 + hstep, voffB); PG8_STAGE(PG8_SA(1, 0), a3, voffA);
            PG8_WAIT_V(8); PG8_WAIT_L(0); PG8_BAR; PG8_MMA(1, 0, At, B0); PG8_MMA(1, 1, At, B1); PG8_BAR; PG8_SCHED;
            } else {
            PG8_LDB(B0, 0, 0); PG8_SCHED; PG8_LDA(At, 0, 0); PG8_STAGE(PG8_SA(1, 1), a1 + hstep, voffA);
            PG8_WAIT_L(8); PG8_BAR; PG8_WAIT_L(0); PG8_MMA(0, 0, At, B0); PG8_BAR; PG8_SCHED;
            PG8_LDB(B1, 0, 1); PG8_STAGE(PG8_SB(0, 0), b2, voffB);
            PG8_BAR; PG8_WAIT_L(0); PG8_MMA(0, 1, At, B1); PG8_BAR;
            PG8_LDA(At, 0, 1); PG8_STAGE(PG8_SA(0, 0), a2, voffA);
            PG8_BAR; PG8_WAIT_L(0); PG8_MMA(1, 0, At, B0); PG8_BAR; PG8_SCHED;
            PG8_STAGE(PG8_SB(0, 1), b2 + hstep, voffB);
            PG8_WAIT_V(6); PG8_BAR; PG8_MMA(1, 1, At, B1); PG8_BAR;
            PG8_LDB(B0, 1, 0); PG8_SCHED; PG8_LDA(At, 1, 0); PG8_STAGE(PG8_SA(0, 1), a2 + hstep, voffA);
            PG8_WAIT_L(8); PG8_BAR; PG8_WAIT_L(0); PG8_MMA(0, 0, At, B0); PG8_BAR; PG8_SCHED;
            PG8_LDB(B1, 1, 1); PG8_STAGE(PG8_SB(1, 0), b3, voffB);
            PG8_BAR; PG8_WAIT_L(0); PG8_MMA(0, 1, At, B1); PG8_BAR;
            PG8_LDA(At, 1, 1); PG8_STAGE(PG8_SA(1, 0), a3, voffA);
            PG8_BAR; PG8_WAIT_L(0); PG8_MMA(1, 0, At, B0); PG8_BAR; PG8_SCHED;
            PG8_STAGE(PG8_SB(1, 1), b3 + hstep, voffB);
            PG8_WAIT_V(6); PG8_BAR; PG8_MMA(1, 1, At, B1); PG8_BAR;
            }
        }
        if constexpr (ALIGN_EPI) { if (wr == 0) PG8_BAR; }
        if constexpr (!Epi::AFTER_DRAIN) { E(acc, cur, wr, wc, fr, fq); S.done(cur); }
        if (!has_next) break;
#pragma unroll
        for (int a = 0; a < 2; ++a)
#pragma unroll
            for (int b = 0; b < 2; ++b)
#pragma unroll
                for (int m = 0; m < 4; ++m)
#pragma unroll
                    for (int n = 0; n < 2; ++n) acc[a][b][m][n] = (f32x4){0.f, 0.f, 0.f, 0.f};
        cur = nxt; cA = nA; cB = nB; ++ui;
        if constexpr (ALIGN_EPI) { if (wr == 1) PG8_BAR; }
    }
    PG8_WAIT_V(0);
    if constexpr (!ALIGN_EPI) { if (wr == 0) PG8_BAR; }
    PG8_BAR;
    if constexpr (Epi::AFTER_DRAIN) { E.fused(acc, cur, wr, wc, fr, fq, lds, wid, lane); S.done(cur); }
#undef PG8_SA
#undef PG8_SB
#undef PG8_STAGE
#undef PG8_LDA
#undef PG8_LDB
#undef PG8_MMA
#undef PG8_WAIT_V
#undef PG8_WAIT_L
#undef PG8_BAR
#undef PG8_SCHED
}
}
namespace attn_body {
using bf16=__hip_bfloat16;
using bf16x8=__attribute__((ext_vector_type(8)))short;
using s16x4=__attribute__((ext_vector_type(4)))short;
using f32x16=__attribute__((ext_vector_type(16)))float;
using u32x4=__attribute__((ext_vector_type(4)))unsigned;
constexpr int BATCH=8,NHEAD=16,SEQ=2048,D=64,DM=NHEAD*D;
constexpr int NW=8,QBLK=32,QB=QBLK*NW,KVBLK=64,NQB=SEQ/QB;
constexpr int ATTN_PITCH=DM, ATTN_UNIT_ROWS=QB;
__device__ __forceinline__ int crow(int r,int hi){return (r&3)+8*(r>>2)+4*hi;}
#define SBAR() __builtin_amdgcn_sched_barrier(0)
__device__ __forceinline__ void cmask(f32x16&p0,f32x16&p1,int jb,int qrel,int hi){
  const float NEG=-INFINITY; int kb=64*jb+4*hi;
  #pragma unroll
  for(int r=0;r<16;++r){int kv=kb+(r&3)+8*(r>>2); if(kv>qrel)p0[r]=NEG; if(kv+32>qrel)p1[r]=NEG;}
}

constexpr int NSLOT=3, SLOTB=8192;
constexpr int LDS_K=0, LDS_V=NSLOT*SLOTB, LDS_WS=2*NSLOT*SLOTB, LDS_OST=LDS_WS+NW*64*4, LDS_CB=LDS_OST+NW*4096, LDS_BYTES=LDS_CB+SEQ*16;
constexpr float C2=0.125f*1.4426950408889634f;
__device__ __forceinline__ void glds16(const void*gsrc,unsigned lds_dst){unsigned keep;
  asm volatile("s_mov_b32 %0, m0\n\ts_mov_b32 m0, %2\n\ts_nop 0\n\tglobal_load_lds_dwordx4 %1, off\n\ts_mov_b32 m0, %0":"=&s"(keep):"v"(gsrc),"s"(lds_dst):"memory");}
__device__ __forceinline__ float max3f(float a,float b,float c){float r;asm("v_max3_f32 %0, %1, %2, %3":"=v"(r):"v"(a),"v"(b),"v"(c));return r;}
__device__ __forceinline__ float max2f(float a,float b){float r;asm("v_max_f32_e32 %0, %1, %2":"=v"(r):"v"(a),"v"(b));return r;}
__device__ __forceinline__ float fadd_s(float a,float b){float r;asm("v_add_f32_e32 %0, %1, %2":"=v"(r):"v"(a),"v"(b));return r;}
__device__ __forceinline__ float fsub_s(float a,float b){float r;asm("v_sub_f32_e32 %0, %1, %2":"=v"(r):"v"(a),"v"(b));return r;}
typedef float f32x2_t __attribute__((ext_vector_type(2))); typedef __bf16 bf16x2_t __attribute__((ext_vector_type(2)));
__device__ __forceinline__ unsigned cvtpk_s(float lo,float hi){f32x2_t v={lo,hi};bf16x2_t b=__builtin_convertvector(v,bf16x2_t);return __builtin_bit_cast(unsigned,b);}
#define WAIT_BAR(N) asm volatile("s_waitcnt vmcnt(" #N ") lgkmcnt(0)\n\ts_barrier":::"memory")

__device__ __forceinline__ void qkt(f32x16&p0,f32x16&p1,const char*Kslot,const bf16x8*qr,const f32x16&negm,int r32,int hi){
  const char*kb=Kslot+hi*1024+r32*16;
  #pragma unroll
  for(int d0=0;d0<4;++d0){
    const bf16x8 b0=*reinterpret_cast<const bf16x8*>(kb+d0*2048);
    const bf16x8 b1=*reinterpret_cast<const bf16x8*>(kb+d0*2048+512);
    if(d0==0){const f32x16 z_=f32x16{};p0=__builtin_amdgcn_mfma_f32_32x32x16_bf16(b0,qr[0],z_,0,0,0);p1=__builtin_amdgcn_mfma_f32_32x32x16_bf16(b1,qr[0],z_,0,0,0);}
    else{p0=__builtin_amdgcn_mfma_f32_32x32x16_bf16(b0,qr[d0],p0,0,0,0);p1=__builtin_amdgcn_mfma_f32_32x32x16_bf16(b1,qr[d0],p1,0,0,0);}}
}
typedef __attribute__((address_space(3))) const char* lds_cptr;
typedef short v4i16_t __attribute__((ext_vector_type(4)));
__device__ __forceinline__ void kload8(bf16x8*kf,lds_cptr kp){
  kf[0]=*(const __attribute__((address_space(3))) bf16x8*)(kp);      kf[1]=*(const __attribute__((address_space(3))) bf16x8*)(kp+512);
  kf[2]=*(const __attribute__((address_space(3))) bf16x8*)(kp+2048); kf[3]=*(const __attribute__((address_space(3))) bf16x8*)(kp+2560);
  kf[4]=*(const __attribute__((address_space(3))) bf16x8*)(kp+4096); kf[5]=*(const __attribute__((address_space(3))) bf16x8*)(kp+4608);
  kf[6]=*(const __attribute__((address_space(3))) bf16x8*)(kp+6144); kf[7]=*(const __attribute__((address_space(3))) bf16x8*)(kp+6656);
}
__device__ __forceinline__ void kload2(bf16x8*kf,lds_cptr kp,int j){ kf[2*j]=*(const __attribute__((address_space(3))) bf16x8*)(kp+j*2048); kf[2*j+1]=*(const __attribute__((address_space(3))) bf16x8*)(kp+j*2048+512); }
__device__ __forceinline__ s16x4 vtr(lds_cptr p){ return __builtin_bit_cast(s16x4,__builtin_amdgcn_ds_read_tr16_b64_v4i16((__attribute__((address_space(3))) v4i16_t*)p)); }
__device__ __forceinline__ float rowmax(const f32x16&p0,const f32x16&p1){
  float a=max3f(p0[0],p0[1],p1[0]),b=max3f(p0[2],p0[3],p1[1]);a=max3f(a,p1[2],p1[3]);
  #pragma unroll
  for(int r=4;r<16;r+=4){a=max3f(a,p0[r],p0[r+1]);b=max3f(b,p0[r+2],p0[r+3]);a=max3f(a,p1[r],p1[r+1]);b=max3f(b,p1[r+2],p1[r+3]);}
  const float m=max2f(a,b);
  auto rr=__builtin_amdgcn_permlane32_swap(__float_as_uint(m),__float_as_uint(m),false,false);
  return max2f(__uint_as_float(rr[0]),__uint_as_float(rr[1]));
}
__device__ __forceinline__ void pv(f32x16*o,int vb,bf16x8 pa0,bf16x8 pa1,bf16x8 pa2,bf16x8 pa3){
  #pragma unroll
  for(int d0=0;d0<2;++d0){s16x4 lo[4],hi[4];
    #pragma unroll
    for(int ks=0;ks<4;++ks){
      asm volatile("ds_read_b64_tr_b16 %0,%1 offset:%c2":"=&v"(lo[ks]):"v"(vb),"i"(d0*4096+ks*1024):"memory");
      asm volatile("ds_read_b64_tr_b16 %0,%1 offset:%c2":"=&v"(hi[ks]):"v"(vb),"i"(d0*4096+ks*1024+512):"memory");}
    asm volatile("s_waitcnt lgkmcnt(0)":::"memory");SBAR();
    #define PK(k) (bf16x8){lo[k][0],lo[k][1],lo[k][2],lo[k][3],hi[k][0],hi[k][1],hi[k][2],hi[k][3]}
    o[d0]=__builtin_amdgcn_mfma_f32_32x32x16_bf16(pa0,PK(0),o[d0],0,0,0);
    o[d0]=__builtin_amdgcn_mfma_f32_32x32x16_bf16(pa1,PK(1),o[d0],0,0,0);
    o[d0]=__builtin_amdgcn_mfma_f32_32x32x16_bf16(pa2,PK(2),o[d0],0,0,0);
    o[d0]=__builtin_amdgcn_mfma_f32_32x32x16_bf16(pa3,PK(3),o[d0],0,0,0);
    #undef PK
  }
}

#ifndef ATTN_STORE16
#define ATTN_STORE16(p,v) (*(u32x4*)(p)=(v))
#endif
template<int THRL> __device__ __forceinline__ void attn_unit(int b,int h,int qb,const bf16*Q,const bf16*__restrict__ K,const bf16*__restrict__ V,bf16*O,char*shm){
  int tid_o=threadIdx.x; asm volatile("":"+v"(tid_o));
  const int tid=tid_o,lane=tid&63,r32=lane&31,hi=lane>>5; const int wid=__builtin_amdgcn_readfirstlane(tid>>6);
  const long rowbase=(long)b*SEQ; const int q0=qb*QB;
  const bf16*Qw=Q+(rowbase+q0+wid*QBLK)*DM+h*D;
  const bf16*Kh=K+rowbase*DM+h*D,*Vh=V+rowbase*DM+h*D;
  const unsigned lds0=(unsigned)(uintptr_t)shm;
  float*wsf=(float*)(shm+LDS_WS)+wid*64;
  const bf16*ksrc=Kh+(long)lane*DM+wid*8;
  const bf16*vsrc=Vh+(long)(16*(wid&3)+(lane>>2))*DM+(wid>>2)*32+(lane&3)*8;
  const unsigned kdst=lds0+LDS_K+wid*1024, vdst=lds0+LDS_V+wid*1024;
  #define DMA_K(t,slot) glds16(ksrc+(long)(t)*KVBLK*DM,(unsigned)__builtin_amdgcn_readfirstlane(kdst+(slot)))
  #define DMA_V(t,slot) glds16(vsrc+(long)(t)*KVBLK*DM,(unsigned)__builtin_amdgcn_readfirstlane(vdst+(slot)))
  const int vb0=(int)(lds0+LDS_V)+((lane>>4)&1)*32+(lane&3)*8+(4*hi+((lane&15)>>2))*64;
  const char*Kbase=shm+LDS_K; bf16x8 kf[8];
  #define BIASMMA(P0,P1,t) do{ const bf16x8 kb0_=*(const __attribute__((address_space(3))) bf16x8*)(cbp+(t)*1024), kb1_=*(const __attribute__((address_space(3))) bf16x8*)(cbp+(t)*1024+512); \
    P0=__builtin_amdgcn_mfma_f32_32x32x16_bf16(kb0_,__builtin_bit_cast(bf16x8,qaug),P0,0,0,0); P1=__builtin_amdgcn_mfma_f32_32x32x16_bf16(kb1_,__builtin_bit_cast(bf16x8,qaug),P1,0,0,0); }while(0)
  #define QROUND(x) __uint_as_float(cvtpk_s((x),0.f)<<16)
  #define UPD_QAUG() do{ qaug.y=hi?0u:(0x3f80u|(__float_as_uint(-mhat)&0xffff0000u)); }while(0)
  const lds_cptr shm3=(lds_cptr)shm; const lds_cptr kp0=shm3+LDS_K+hi*1024+r32*16; const lds_cptr vp0=shm3+LDS_V+((lane>>4)&1)*32+(lane&3)*8+(4*hi+((lane&15)>>2))*64;
  const lds_cptr cbp=shm3+LDS_CB+r32*16;
  u32x4 qaug=(u32x4){hi?0u:0x3f803f80u,hi?0u:0x00003f80u,0u,0u};
  typedef unsigned u32x2_t __attribute__((ext_vector_type(2)));
  const int NT=(q0+QB)/KVBLK;
  DMA_K(0,0);DMA_V(0,0);DMA_K(1,SLOTB);
  bf16x8 qr[4];
  #pragma unroll
  for(int d0=0;d0<4;++d0)qr[d0]=*reinterpret_cast<const bf16x8*>(&Qw[(long)r32*DM+d0*16+hi*8]);
  float mhat=0.f,l_reg=0.f;f32x16 o[2];{float zz_=0.f;asm volatile("":"+v"(zz_));_Pragma("unroll") for(int r=0;r<16;++r){o[0][r]=zz_;o[1][r]=zz_;}}    const f32x16 negm=f32x16{};
  const int qrel=wid*QBLK+r32;
  #define CMASK(P0,P1,t) do{int jb_=(t)-(NT-4); if(jb_>=0)cmask(P0,P1,jb_,qrel,hi);}while(0)
  bool resc=false;
  #define START(P0,P1) do{ const float rm=rowmax(P0,P1); resc=false; \
    { const float tq_=QROUND(mhat+rm); const float dl=tq_-mhat; mhat=tq_; \
      _Pragma("unroll") for(int r=0;r<16;++r){P0[r]=fsub_s(P0[r],dl);P1[r]=fsub_s(P1[r],dl);} \
      UPD_QAUG(); } \
    _Pragma("unroll") for(int r=0;r<16;++r)P0[r]=__builtin_amdgcn_exp2f(P0[r]); }while(0)
  #define RESC() do{ if(resc){ asm volatile("s_waitcnt lgkmcnt(0)":::"memory"); \
      _Pragma("unroll") for(int d_=0;d_<2;++d_) _Pragma("unroll") for(int r=0;r<16;++r)o[d_][r]*=wsf[crow(r,hi)]; } }while(0)
  f32x16 pA0,pA1,pB0,pB1;
  int sl_prev=0,sl_cur=0,sl_next=SLOTB;
  #define ROT() do{sl_prev=sl_cur;sl_cur=sl_next;sl_next=(sl_next==(NSLOT-1)*SLOTB)?0:sl_next+SLOTB;}while(0)
  DMA_K(2,2*SLOTB);
  WAIT_BAR(3);
  qkt(pA0,pA1,Kbase,qr,negm,r32,hi);BIASMMA(pA0,pA1,0);asm volatile("s_nop 15\n\ts_nop 7":"+v"(pA0),"+v"(pA1));CMASK(pA0,pA1,0);
  START(pA0,pA1);
  _Pragma("unroll") for(int r=0;r<16;++r)pA1[r]=__builtin_amdgcn_exp2f(pA1[r]);
  WAIT_BAR(0);
  DMA_K(3,0);DMA_V(1,SLOTB);
  ROT();
  kload8(kf,kp0+sl_cur);
  WAIT_BAR(2);
  s16x4 vlo[8],vhi[8]; u32x4 pw0,pw1,pw2,pw3;
  #define PKW(P,B) cvtpk_s(P[B],P[B+1])
  #define PAF(k) __builtin_bit_cast(bf16x8,pw##k)
  #define VFR(i) (bf16x8){vlo[i][0],vlo[i][1],vlo[i][2],vlo[i][3],vhi[i][0],vhi[i][1],vhi[i][2],vhi[i][3]}
  #define PIN(x) asm volatile("":"+v"(x))
  #define MX3(a,b,c) __builtin_fmaxf(__builtin_fmaxf((a),(b)),(c))
  #define GAPA(MF,A0,A1,A2,A3,W0,W1,PW) do{ MF; sacc+=A0; sacc+=A1; sacc+=A2; sacc+=A3; PIN(sacc); W0; W1; PIN(PW); SBAR(); }while(0)
  #define EX(v) __builtin_amdgcn_exp2f(v)
  #define GAPB(MF,X,B) do{ MF; X[B]=EX(X[B]); X[B+1]=EX(X[B+1]); X[B+2]=EX(X[B+2]); X[B+3]=EX(X[B+3]); PIN(X); SBAR(); }while(0)
  #define VRD(i) do{ vlo[i]=vtr(vp_+(((i)>>2)*4096+((i)&3)*1024)); vhi[i]=vtr(vp_+(((i)>>2)*4096+((i)&3)*1024+512)); }while(0)
  #define KRD(G,j) do{ if(G){ kload2(kf,kp0+sl_next,j); SBAR(); } }while(0)
  #define STEP(C0,C1,P0,P1,t,GK,GV,GL) do{ SBAR(); \
    const lds_cptr vp_=vp0+sl_prev; \
    const bf16x8 kbA_=*(const __attribute__((address_space(3))) bf16x8*)(cbp+(t)*1024), kbB_=*(const __attribute__((address_space(3))) bf16x8*)(cbp+(t)*1024+512);     \
    VRD(0); SBAR(); float sacc=(P0[0]+P0[1]); \
    GAPA(C0=__builtin_amdgcn_mfma_f32_32x32x16_bf16(kf[0],qr[0],negm,0,0,0), P0[2],P0[3],P0[4],P0[5],     pw0[0]=PKW(P0,0), pw0[1]=PKW(P0,2), pw0); \
    VRD(4); SBAR(); GAPA(C1=__builtin_amdgcn_mfma_f32_32x32x16_bf16(kf[1],qr[0],negm,0,0,0), P0[6],P0[7],P0[8],P0[9],     pw0[2]=PKW(P0,4), pw0[3]=PKW(P0,6), pw0); \
    C0=__builtin_amdgcn_mfma_f32_32x32x16_bf16(kbA_,__builtin_bit_cast(bf16x8,qaug),C0,0,0,0); C1=__builtin_amdgcn_mfma_f32_32x32x16_bf16(kbB_,__builtin_bit_cast(bf16x8,qaug),C1,0,0,0); SBAR(); \
    VRD(1); SBAR(); GAPA(C0=__builtin_amdgcn_mfma_f32_32x32x16_bf16(kf[2],qr[1],C0,0,0,0),   P0[10],P0[11],P0[12],P0[13], pw1[0]=PKW(P0,8), pw1[1]=PKW(P0,10), pw1); \
    VRD(5); SBAR(); GAPA(C1=__builtin_amdgcn_mfma_f32_32x32x16_bf16(kf[3],qr[1],C1,0,0,0),   P0[14],P0[15],P1[0],P1[1],   pw1[2]=PKW(P0,12),pw1[3]=PKW(P0,14), pw1); \
    VRD(2); SBAR(); GAPA(C0=__builtin_amdgcn_mfma_f32_32x32x16_bf16(kf[4],qr[2],C0,0,0,0),   P1[2],P1[3],P1[4],P1[5],     pw2[0]=PKW(P1,0), pw2[1]=PKW(P1,2), pw2); \
    VRD(6); SBAR(); GAPA(C1=__builtin_amdgcn_mfma_f32_32x32x16_bf16(kf[5],qr[2],C1,0,0,0),   P1[6],P1[7],P1[8],P1[9],     pw2[2]=PKW(P1,4), pw2[3]=PKW(P1,6), pw2); \
    VRD(3); SBAR(); GAPA(C0=__builtin_amdgcn_mfma_f32_32x32x16_bf16(kf[6],qr[3],C0,0,0,0),   P1[10],P1[11],P1[12],P1[13], pw3[0]=PKW(P1,8), pw3[1]=PKW(P1,10), pw3); \
    VRD(7); SBAR(); GAPA(C1=__builtin_amdgcn_mfma_f32_32x32x16_bf16(kf[7],qr[3],C1,0,0,0),   P1[14],P1[15],0.f,0.f,       pw3[2]=PKW(P1,12),pw3[3]=PKW(P1,14), pw3); \
    l_reg+=sacc; \
    if(GK){DMA_K((t)+3,sl_cur);} if(GV){DMA_V((t)+1,sl_next);} \
    CMASK(C0,C1,t); \
    { float a=MX3(C0[0],C0[1],C1[0]),b=MX3(C0[2],C0[3],C1[1]); a=MX3(a,C1[2],C1[3]); \
      _Pragma("unroll") for(int r=4;r<16;r+=4){a=MX3(a,C0[r],C0[r+1]);b=MX3(b,C0[r+2],C0[r+3]);a=MX3(a,C1[r],C1[r+1]);b=MX3(b,C1[r+2],C1[r+3]);} \
      float rm=__builtin_fmaxf(a,b); { auto rr=__builtin_amdgcn_permlane32_swap(__float_as_uint(rm),__float_as_uint(rm),false,false); rm=__builtin_fmaxf(__uint_as_float(rr[0]),__uint_as_float(rr[1])); } \
      resc=false; \
      if(__builtin_expect(__any(rm>(float)THRL),0)){ const float tq_=QROUND(mhat+__builtin_fmaxf(rm,0.f)); const float dl=tq_-mhat; mhat=tq_; \
        _Pragma("unroll") for(int r=0;r<16;++r){C0[r]-=dl;C1[r]-=dl;} \
        UPD_QAUG(); \
        const float f=__builtin_amdgcn_exp2f(-dl); l_reg*=f; if(hi==0)wsf[r32]=f; resc=true; } } \
    SBAR(); \
    GAPB(o[0]=__builtin_amdgcn_mfma_f32_32x32x16_bf16(PAF(0),VFR(0),o[0],0,0,0), C0,0); \
    GAPB(o[1]=__builtin_amdgcn_mfma_f32_32x32x16_bf16(PAF(0),VFR(4),o[1],0,0,0), C0,4); \
    KRD(GL,0); GAPB(o[0]=__builtin_amdgcn_mfma_f32_32x32x16_bf16(PAF(1),VFR(1),o[0],0,0,0), C0,8); \
    KRD(GL,1); GAPB(o[1]=__builtin_amdgcn_mfma_f32_32x32x16_bf16(PAF(1),VFR(5),o[1],0,0,0), C0,12); \
    KRD(GL,2); GAPB(o[0]=__builtin_amdgcn_mfma_f32_32x32x16_bf16(PAF(2),VFR(2),o[0],0,0,0), C1,0); \
    KRD(GL,3); GAPB(o[1]=__builtin_amdgcn_mfma_f32_32x32x16_bf16(PAF(2),VFR(6),o[1],0,0,0), C1,4); \
    GAPB(o[0]=__builtin_amdgcn_mfma_f32_32x32x16_bf16(PAF(3),VFR(3),o[0],0,0,0), C1,8); \
    GAPB(o[1]=__builtin_amdgcn_mfma_f32_32x32x16_bf16(PAF(3),VFR(7),o[1],0,0,0), C1,12); \
    }while(0)
  int t=1;
  #undef CMASK
  #define CMASK(P0,P1,t) do{}while(0)
  for(;t+5<NT;t+=2){
    STEP(pB0,pB1,pA0,pA1,t,true,true,true);     WAIT_BAR(2); RESC(); ROT();
    STEP(pA0,pA1,pB0,pB1,t+1,true,true,true);   WAIT_BAR(2); RESC(); ROT();
  }
  #undef CMASK
  #define CMASK(P0,P1,t) do{int jb_=(t)-(NT-4); if(jb_>=0)cmask(P0,P1,jb_,qrel,hi);}while(0)
  #define ENDW(tt) do{ if((tt)+3<NT){WAIT_BAR(2);} else if((tt)+2<NT){WAIT_BAR(1);} else {WAIT_BAR(0);} }while(0)
  for(;t+1<NT;t+=2){
    STEP(pB0,pB1,pA0,pA1,t,(t+3<NT),(t+1<NT),(t+1<NT));       ENDW(t);   RESC(); ROT();
    STEP(pA0,pA1,pB0,pB1,t+1,(t+4<NT),(t+2<NT),(t+2<NT));     ENDW(t+1); RESC(); ROT();
  }
  STEP(pB0,pB1,pA0,pA1,NT-1,false,false,false); RESC();
  { float sacc=pB0[0]+pB0[1]; _Pragma("unroll") for(int r=2;r<16;++r)sacc+=pB0[r]; _Pragma("unroll") for(int r=0;r<16;++r)sacc+=pB1[r]; l_reg+=sacc;
    pw0=(u32x4){PKW(pB0,0),PKW(pB0,2),PKW(pB0,4),PKW(pB0,6)};pw1=(u32x4){PKW(pB0,8),PKW(pB0,10),PKW(pB0,12),PKW(pB0,14)};pw2=(u32x4){PKW(pB1,0),PKW(pB1,2),PKW(pB1,4),PKW(pB1,6)};pw3=(u32x4){PKW(pB1,8),PKW(pB1,10),PKW(pB1,12),PKW(pB1,14)};
    SBAR(); pv(o,vb0+sl_cur,PAF(0),PAF(1),PAF(2),PAF(3)); }
  #undef PKW
  #undef PAF
  #undef VFR
  #undef PIN
  #undef MX3
  #undef GAPA
  #undef GAPB
  #undef EX
  #undef VRD
  #undef KRD
  #undef STEP
  #undef ENDW
  {auto rr=__builtin_amdgcn_permlane32_swap(__float_as_uint(l_reg),__float_as_uint(l_reg),false,false);l_reg=__uint_as_float(rr[0])+__uint_as_float(rr[1]);}
  if(hi==0)wsf[32+r32]=l_reg;asm volatile("s_waitcnt lgkmcnt(0)":::"memory");
  float rli[16];
  #pragma unroll
  for(int r=0;r<16;++r)rli[r]=__builtin_amdgcn_rcpf(wsf[32+crow(r,hi)]);
  bf16*Ow=O+(rowbase+q0+wid*QBLK)*DM+h*D;
  { bf16*stg=(bf16*)(shm+LDS_OST)+wid*2048;
    #pragma unroll
    for(int r=0;r<16;++r){const int orow=crow(r,hi);
      #pragma unroll
      for(int d0=0;d0<2;++d0)stg[orow*64+d0*32+r32]=__float2bfloat16(o[d0][r]*rli[r]);}
    asm volatile("s_waitcnt lgkmcnt(0)":::"memory");
    #pragma unroll
    for(int i=0;i<4;++i){const int row=i*8+(lane>>3),ch=lane&7; const u32x4 v=*(const u32x4*)(stg+row*64+ch*8); ATTN_STORE16(Ow+(long)row*DM+ch*8,v);} }
  asm volatile("s_waitcnt lgkmcnt(0)\n\ts_barrier":::"memory");
  #undef DMA_K
  #undef DMA_V
  #undef CMASK
  #undef START
  #undef RESC
  #undef ROT
  #undef BIASMMA
  #undef UPD_QAUG
  #undef QROUND
}
constexpr int ATTN_LDS_BYTES=LDS_BYTES;
#undef SBAR
#undef WAIT_BAR
}
namespace mls {
#define MLAS __attribute__((address_space(3)))
typedef unsigned short bf16_t;
typedef short bf16x8 __attribute__((ext_vector_type(8)));
typedef float f32x4 __attribute__((ext_vector_type(4)));
typedef unsigned u32x4 __attribute__((ext_vector_type(4)));
typedef unsigned u32x2 __attribute__((ext_vector_type(2)));
constexpr int T = 2048, DM = 1024, QS = 264, TS = 72;
constexpr int L_Q = 0, L_K = L_Q + 64 * QS * 2, L_KWT = L_K + 64 * QS * 2, L_VT = L_KWT + 256 * TS * 2, L_SP = L_VT + 64 * TS * 2, L_XCH = L_SP + 64 * TS * 2, L_SM = L_XCH + 8 * 2 * 64 * 16;
constexpr int F_A2 = 0, F_R2 = 64, F_WI = 128, F_FL = 192, F_DENP = 256, F_NQ = 384, F_NVEC = 448, F_STATP = 704, F_END = F_STATP + 4 * 64 * 2;
constexpr int LDS_BYTES = L_SM + F_END * 4;
static_assert(LDS_BYTES <= 147456 - 1024, "mLSTM LDS");
__device__ __forceinline__ unsigned cvtpk(float lo, float hi) { unsigned r; asm volatile("v_cvt_pk_bf16_f32 %0, %1, %2" : "=v"(r) : "v"(lo), "v"(hi)); return r; }
__device__ __forceinline__ float blo(unsigned w) { return __uint_as_float(w << 16); }
__device__ __forceinline__ float bhi(unsigned w) { return __uint_as_float(w & 0xffff0000u); }
#define MLS_LBAR() do { asm volatile("s_waitcnt lgkmcnt(0)" ::: "memory"); __builtin_amdgcn_s_barrier(); asm volatile("" ::: "memory"); } while (0)
#define MMA16(a, b, c) __builtin_amdgcn_mfma_f32_16x16x32_bf16((a), (b), (c), 0, 0, 0)

__device__ __forceinline__ void mlstm_unit(int b, int h, int vs, const bf16_t* Q, const bf16_t* K, bf16_t* VH, const float* mtab, float* stats, MLAS unsigned char* lds, const int pm  ) {
    int tid_o = threadIdx.x; asm volatile("" : "+v"(tid_o));
    const int tid0 = tid_o, w = __builtin_amdgcn_readfirstlane(tid0 >> 6);
    MLAS float* sm = (MLAS float*)(lds + L_SM);
    const size_t row0 = (size_t)b * T;
    const float* mt = mtab + (size_t)(b * 4 + h) * 5 * T;
    const bf16_t* qsrc = Q + (row0 + 4 * (tid0 >> 5)) * DM + h * 256 + 8 * (tid0 & 31);
    const bf16_t* ksrc = K + (row0 + 4 * (tid0 >> 5)) * DM + h * 256 + 8 * (tid0 & 31);
    const bf16_t* vsrc = VH + (row0 + (tid0 >> 3)) * DM + h * 256 + 64 * vs + 8 * (tid0 & 7);
    const int vb = w & 3, dh = w >> 2;
    f32x4 Cacc[8];
#pragma unroll
    for (int i = 0; i < 8; ++i) Cacc[i] = (f32x4){0.f, 0.f, 0.f, 0.f};
    if (tid0 < 256) sm[F_NVEC + tid0] = 0.f;
    u32x4 qraw[4], kraw[4], vraw; f32x4 wend4; float ga2 = 0.f, gr2 = 0.f, gwi = 0.f, gfl = 0.f;
#define MLS_PREFETCH(c, tid) do { const size_t ro_ = (size_t)(c) * 64 * DM; \
        _Pragma("unroll") for (int j_ = 0; j_ < 4; ++j_) { qraw[j_] = *(const u32x4*)(qsrc + ro_ + (size_t)j_ * DM); kraw[j_] = *(const u32x4*)(ksrc + ro_ + (size_t)j_ * DM); } \
        vraw = *(const u32x4*)(vsrc + ro_); \
        wend4 = *(const f32x4*)(mt + 4 * T + (c) * 64 + 4 * ((tid) >> 5)); \
        if (tid < 64) { ga2 = mt[(c) * 64 + tid]; gr2 = mt[T + (c) * 64 + tid]; gwi = mt[2 * T + (c) * 64 + tid]; gfl = mt[3 * T + (c) * 64 + tid]; } } while (0)
    MLS_PREFETCH(0, tid0);
#pragma unroll 1
    for (int c = 0; c < 32; ++c) {
        int tid_i = tid0; asm volatile("" : "+v"(tid_i));
        const int tid = tid_i, lane = tid & 63, g = lane >> 4, c16 = lane & 15, cg = tid & 31, rg = tid >> 5, vc = tid & 7, vr = tid >> 3;
        if (!(pm & 16)) {
#pragma unroll
        for (int j = 0; j < 4; ++j) { *(MLAS u32x4*)(lds + L_Q + ((4 * rg + j) * QS + 8 * cg) * 2) = qraw[j]; *(MLAS u32x4*)(lds + L_K + ((4 * rg + j) * QS + 8 * cg) * 2) = kraw[j]; }
        {
#pragma unroll
            for (int e2 = 0; e2 < 4; ++e2) {
                u32x2 lo, hi;
                lo.x = cvtpk(blo(kraw[0][e2]) * wend4[0], blo(kraw[1][e2]) * wend4[1]); lo.y = cvtpk(blo(kraw[2][e2]) * wend4[2], blo(kraw[3][e2]) * wend4[3]);
                hi.x = cvtpk(bhi(kraw[0][e2]) * wend4[0], bhi(kraw[1][e2]) * wend4[1]); hi.y = cvtpk(bhi(kraw[2][e2]) * wend4[2], bhi(kraw[3][e2]) * wend4[3]);
                const int so = (((rg >> 1) ^ (cg & 7)) * 8 + 4 * (rg & 1)) * 2;
                *(MLAS u32x2*)(lds + L_KWT + (8 * cg + 2 * e2) * TS * 2 + so) = lo; *(MLAS u32x2*)(lds + L_KWT + (8 * cg + 2 * e2 + 1) * TS * 2 + so) = hi; }
        }
        {
#pragma unroll
            for (int e2 = 0; e2 < 4; ++e2) {
                const int so = (((vr >> 3) ^ (vc & 7)) * 8 + (vr & 7)) * 2;
                *(MLAS unsigned short*)(lds + L_VT + (8 * vc + 2 * e2) * TS * 2 + so) = (unsigned short)(vraw[e2] & 0xffffu);
                *(MLAS unsigned short*)(lds + L_VT + (8 * vc + 2 * e2 + 1) * TS * 2 + so) = (unsigned short)(vraw[e2] >> 16); }
        }
        if (tid < 64) { sm[F_A2 + tid] = ga2; sm[F_R2 + tid] = gr2; sm[F_WI + tid] = gwi; sm[F_FL + tid] = gfl; }
        }
        __syncthreads();
        if (c + 1 < 32 && !(pm & 8192)) MLS_PREFETCH(c + 1, tid);
        if (c > 0 && tid < 64 && !(pm & 4096)) {
            float s1 = 0.f, s2 = 0.f;
#pragma unroll
            for (int k = 0; k < 4; ++k) { s1 += sm[F_STATP + (k * 64 + tid) * 2]; s2 += sm[F_STATP + (k * 64 + tid) * 2 + 1]; }
            float* sp = stats + ((row0 + (size_t)(c - 1) * 64 + tid) * 4 + h) * 2; unsafeAtomicAdd(sp, s1); unsafeAtomicAdd(sp + 1, s2); }
        {
            const int tb = w & 3, sh = w >> 2, t = 16 * tb + c16;
            bf16x8 qf[8];
#pragma unroll
            for (int j = 0; j < 8; ++j) qf[j] = *(const MLAS bf16x8*)(lds + L_Q + (t * QS + 32 * j + 8 * g) * 2);
            const float r2t = sm[F_R2 + t]; float rowsum = 0.f;
#pragma unroll
            for (int blk = 0; blk < 2; ++blk) { const int sb = 2 * sh + blk; u32x2 o; o.x = 0u; o.y = 0u;
                if (sb <= tb && !(pm & 32)) {
                    f32x4 acc = (f32x4){0.f, 0.f, 0.f, 0.f};
#pragma unroll
                    for (int j = 0; j < 8; ++j) { const bf16x8 kf = *(const MLAS bf16x8*)(lds + L_K + ((16 * sb + c16) * QS + 32 * j + 8 * g) * 2); acc = MMA16(kf, qf[j], acc); }
                    const f32x4 a2v = *(const MLAS f32x4*)(sm + F_A2 + 16 * sb + 4 * g); float sp[4];
#pragma unroll
                    for (int i = 0; i < 4; ++i) { const int s = 16 * sb + 4 * g + i; const float wg = __builtin_amdgcn_exp2f(a2v[i] - r2t); sp[i] = (s <= t) ? acc[i] * wg : 0.f; rowsum += sp[i]; }
                    o.x = cvtpk(sp[0], sp[1]); o.y = cvtpk(sp[2], sp[3]); }
                *(MLAS u32x2*)(lds + L_SP + (t * TS + 16 * sb + 4 * g) * 2) = o; }
            rowsum += __shfl_xor(rowsum, 16); rowsum += __shfl_xor(rowsum, 32);
            if (g == 0) sm[F_DENP + sh * 64 + t] = rowsum;
        }
        if (!(pm & 64)) {
            const int t = tid >> 3, part = tid & 7; float s = 0.f;
#pragma unroll
            for (int j = 0; j < 4; ++j) { const u32x4 qv = *(const MLAS u32x4*)(lds + L_Q + (t * QS + 32 * part + 8 * j) * 2);
                const f32x4 n0 = *(const MLAS f32x4*)(sm + F_NVEC + 32 * part + 8 * j), n1 = *(const MLAS f32x4*)(sm + F_NVEC + 32 * part + 8 * j + 4);
                s += blo(qv.x) * n0[0] + bhi(qv.x) * n0[1] + blo(qv.y) * n0[2] + bhi(qv.y) * n0[3] + blo(qv.z) * n1[0] + bhi(qv.z) * n1[1] + blo(qv.w) * n1[2] + bhi(qv.w) * n1[3]; }
            s += __shfl_xor(s, 1); s += __shfl_xor(s, 2); s += __shfl_xor(s, 4);
            if (part == 0) sm[F_NQ + t] = s;
        }
        f32x4 accI[4];
        {
            bf16x8 cf[4];
#pragma unroll
            for (int j = 0; j < 4; ++j) { u32x4 p; p.x = cvtpk(Cacc[2 * j][0], Cacc[2 * j][1]); p.y = cvtpk(Cacc[2 * j][2], Cacc[2 * j][3]); p.z = cvtpk(Cacc[2 * j + 1][0], Cacc[2 * j + 1][1]); p.w = cvtpk(Cacc[2 * j + 1][2], Cacc[2 * j + 1][3]); cf[j] = __builtin_bit_cast(bf16x8, p); }
#pragma unroll
            for (int tb = 0; tb < 4; ++tb) { const int t = 16 * tb + c16; accI[tb] = (f32x4){0.f, 0.f, 0.f, 0.f};
                if (!(pm & 128))
#pragma unroll
                for (int j = 0; j < 4; ++j) { const u32x2 q0 = *(const MLAS u32x2*)(lds + L_Q + (t * QS + 128 * dh + 32 * j + 4 * g) * 2), q1 = *(const MLAS u32x2*)(lds + L_Q + (t * QS + 128 * dh + 32 * j + 16 + 4 * g) * 2);
                    const bf16x8 qp = __builtin_bit_cast(bf16x8, (u32x4){q0.x, q0.y, q1.x, q1.y}); accI[tb] = MMA16(cf[j], qp, accI[tb]); } }
#pragma unroll
            for (int k = 0; k < 2; ++k) *(MLAS f32x4*)(lds + L_XCH + ((w * 2 + k) * 64 + lane) * 16) = dh ? accI[k] : accI[2 + k];
        }
        MLS_LBAR();
        bf16x8 vf[2];
#pragma unroll
        for (int j = 0; j < 2; ++j) vf[j] = *(const MLAS bf16x8*)(lds + L_VT + (16 * vb + c16) * TS * 2 + (((4 * j + g) ^ ((2 * vb + (c16 >> 3)) & 7)) * 16));
#pragma unroll
        for (int k = 0; k < ((pm & 256) ? 0 : 2); ++k) { const int tb = 2 * dh + k, t = 16 * tb + c16;
            const f32x4 other = *(const MLAS f32x4*)(lds + L_XCH + (((w ^ 4) * 2 + k) * 64 + lane) * 16);
            const float wi = sm[F_WI + t];
            f32x4 acc = ((dh ? accI[2 + k] : accI[k]) + other) * wi;
#pragma unroll
            for (int j = 0; j < 2; ++j) { const bf16x8 sf = *(const MLAS bf16x8*)(lds + L_SP + (t * TS + 32 * j + 8 * g) * 2); acc = MMA16(vf[j], sf, acc); }
            const float den = sm[F_DENP + t] + sm[F_DENP + 64 + t] + wi * sm[F_NQ + t];
            const float sc = 1.0f / fmaxf(fabsf(den), sm[F_FL + t]);
            const f32x4 hv = acc * sc;
            u32x2 o; o.x = cvtpk(hv[0], hv[1]); o.y = cvtpk(hv[2], hv[3]);
            if (!(pm & 2048)) *(u32x2*)(VH + (row0 + (size_t)c * 64 + t) * DM + h * 256 + 64 * vs + 16 * vb + 4 * g) = o;
            float s1 = (hv[0] + hv[1]) + (hv[2] + hv[3]), s2 = (hv[0] * hv[0] + hv[1] * hv[1]) + (hv[2] * hv[2] + hv[3] * hv[3]);
            s1 += __shfl_xor(s1, 16); s1 += __shfl_xor(s1, 32); s2 += __shfl_xor(s2, 16); s2 += __shfl_xor(s2, 32);
            if (g == 0) { sm[F_STATP + (vb * 64 + t) * 2] = s1; sm[F_STATP + (vb * 64 + t) * 2 + 1] = s2; } }
        const float decay = sm[F_WI + 63];
#pragma unroll
        for (int nb = 0; nb < 8; ++nb) { Cacc[nb] = Cacc[nb] * decay;
            if (!(pm & 512))
#pragma unroll
            for (int j = 0; j < 2; ++j) { const bf16x8 kf = *(const MLAS bf16x8*)(lds + L_KWT + (128 * dh + 16 * nb + c16) * TS * 2 + (((4 * j + g) ^ ((2 * nb + (c16 >> 3)) & 7)) * 16)); Cacc[nb] = MMA16(kf, vf[j], Cacc[nb]); } }
        if (tid < 256 && !(pm & 1024)) { float s = 0.f;
#pragma unroll
            for (int j = 0; j < 8; ++j) { const u32x4 kv = *(const MLAS u32x4*)(lds + L_KWT + (tid * TS + 8 * j) * 2); s += (blo(kv.x) + bhi(kv.x)) + (blo(kv.y) + bhi(kv.y)) + (blo(kv.z) + bhi(kv.z)) + (blo(kv.w) + bhi(kv.w)); }
            sm[F_NVEC + tid] = decay * sm[F_NVEC + tid] + s; }
        MLS_LBAR();
    }
    if (tid0 < 64) { float s1 = 0.f, s2 = 0.f;
#pragma unroll
            for (int k = 0; k < 4; ++k) { s1 += sm[F_STATP + (k * 64 + tid0) * 2]; s2 += sm[F_STATP + (k * 64 + tid0) * 2 + 1]; }
            float* sp = stats + ((row0 + (size_t)31 * 64 + tid0) * 4 + h) * 2; unsafeAtomicAdd(sp, s1); unsafeAtomicAdd(sp + 1, s2); }
    __syncthreads();
#undef MLS_PREFETCH
}
#undef MMA16
#undef MLS_LBAR
#undef MLAS
}

constexpr int BATCH = 8, T = 2048, D = 1024, M = BATCH * T, FF = 2816, NA = 6144, NAC = 6176  , NB = 4096, NHM = 4, NHF = 16;
constexpr int NWAVES = 8;
constexpr float C2 = 0.125f * 1.4426950408889634f;
constexpr size_t MiB = 1u << 20;
constexpr size_t WS_CTL = 0, CTL_ZERO_BYTES = 1 * MiB;
constexpr size_t CTL_SS = 65536;
constexpr size_t CTL_STATS = 512 * 1024;
constexpr size_t WS_BIASA = 1 * MiB, WS_BIASB = 1 * MiB + 65536;
constexpr size_t WS_GATES = 2 * MiB;
constexpr size_t WS_XB = 8 * MiB;
constexpr size_t WS_P = 40 * MiB, SLOT = 32 * MiB;
constexpr size_t WS_H1 = 40 * MiB, WS_W1GU = 128 * MiB, WS_W1D = 140 * MiB;
constexpr size_t WS_WINA = 232 * MiB, WS_WINB = 245 * MiB;
constexpr size_t WS_Y = 40 * MiB;
constexpr size_t WS_W2GU = 232 * MiB, WS_WOUT = 243 * MiB;
constexpr size_t WS_W2D = 86 * MiB;
constexpr size_t WS_H2 = 104 * MiB;
constexpr size_t WS_END = 256 * MiB;
static_assert(WS_H1 + (size_t)M * FF * 2 <= WS_W1GU && WS_W1GU + (size_t)2 * FF * D * 2 <= WS_W1D && WS_W1D + (size_t)D * FF * 2 <= WS_WINA, "map1");
static_assert(WS_WINA + (size_t)NA * D * 2 <= WS_WINB && WS_WINB + (size_t)NB * D * 2 <= WS_END, "map2");
static_assert(WS_W2GU + (size_t)2 * FF * D * 2 <= WS_WOUT && WS_WOUT + (size_t)D * D * 2 <= WS_WINB && WS_W2D + (size_t)D * FF * 2 <= WS_H2 && WS_H2 + (size_t)M * FF * 2 <= WS_WINA, "map3");

constexpr int RING_BYTES = 131072, LDS_BYTES = 147456;
#ifndef PROBE_K
#define PROBE_K -1
#endif
#ifndef PROBE_MODE
#define PROBE_MODE 0
#endif

#define GAS __attribute__((address_space(1)))
#define LAS __attribute__((address_space(3)))
typedef unsigned short bf16;
typedef unsigned v4u __attribute__((ext_vector_type(4)));
typedef unsigned v2u __attribute__((ext_vector_type(2)));
typedef float f32x4 __attribute__((ext_vector_type(4)));
__device__ __forceinline__ unsigned f2bf(float f) { unsigned u = __builtin_bit_cast(unsigned, f); return (u + 0x7fffu + ((u >> 16) & 1u)) >> 16; }
__device__ __forceinline__ unsigned pk2(float lo, float hi) { return f2bf(lo) | (f2bf(hi) << 16); }
__device__ __forceinline__ float bf2f(bf16 v) { return __uint_as_float((unsigned)v << 16); }
__device__ __forceinline__ float wave_sum(float v) {
#pragma unroll
    for (int o = 1; o < 64; o <<= 1) v += __shfl_xor(v, o);
    return v;
}
__device__ __forceinline__ float log_sigmoid(float x) { return fminf(x, 0.f) - log1pf(expf(-fabsf(x))); }

struct Args { const float* in[17]; float* out; unsigned char* ws; int ph_lo, ph_hi, coop, mode; };

struct MatDesc { const float* s0; const float* s1; const float* scale; bf16* dst; int K, Nsrc, nrows, kind; };
__device__ __forceinline__ int inA_src(int c) {
    if (c < 6144) { const int slot = c >> 10, j = c & 1023; const int st = slot == 0 ? 0 : slot == 1 ? 1024 : slot == 2 ? 2048 : slot == 3 ? 4104 : slot == 4 ? 5128 : 6152; return st + j; }
    const int g = c - 6144; if (g < 4) return 4096 + g; if (g < 8) return 4100 + (g - 4); if (g < 24) return 7176 + (g - 8); return -1;
}
__device__ __forceinline__ int inB_src(int c) {
    const int pn = c >> 8, ct = c & 255, bj = ct >> 7, wc = (ct >> 5) & 3, fq = (ct >> 3) & 3, n = (ct >> 2) & 1, i = ct & 3, j = 64 * pn + 16 * wc + 4 * fq + i;
    if (bj == 0) return n == 0 ? 3072 + j : 7192 + j;
    return n == 0 ? 8216 + j : -1;
}
__device__ __forceinline__ const float* src_col(const MatDesc& d, int c) {
    if (d.kind == 0) { const int pn = c >> 8, bj = (c >> 7) & 1, r = c & 127; const long long dl = (long long)((const char*)d.s1 - (const char*)d.s0) * bj; return (const float*)((const char*)d.s0 + dl) + 128 * pn + r; }
    if (d.kind == 1) return d.s0 + c;
    const int s = d.kind == 2 ? inA_src(c) : inB_src(c); return s < 0 ? nullptr : d.s0 + s;
}
__device__ __forceinline__ void transpose_item(const MatDesc& d, LAS float* scr, int item, int lane) {
    const int nblk = d.nrows / 32, kb = item / nblk, nb = item % nblk, k0 = 64 * kb, n0 = 32 * nb;
    const int q4 = lane & 7, kr = lane >> 3;
    const float* sp = src_col(d, n0 + 4 * q4);
#pragma unroll
    for (int i = 0; i < 8; ++i) { const int kk = kr + 8 * i; f32x4 v = {0.f, 0.f, 0.f, 0.f};
        if (sp) { v = *(const f32x4*)(sp + (size_t)(k0 + kk) * d.Nsrc); if (d.scale) v = v * d.scale[k0 + kk]; }
        scr[kk * 33 + 4 * q4] = v.x; scr[kk * 33 + 4 * q4 + 1] = v.y; scr[kk * 33 + 4 * q4 + 2] = v.z; scr[kk * 33 + 4 * q4 + 3] = v.w; }
    asm volatile("s_waitcnt lgkmcnt(0)" ::: "memory");
    const int c = lane & 7;
#pragma unroll
    for (int j = 0; j < 4; ++j) { const int n = (lane >> 3) + 8 * j; const LAS float* s = scr + (8 * c) * 33 + n;
        v4u o; o.x = pk2(s[0 * 33], s[1 * 33]); o.y = pk2(s[2 * 33], s[3 * 33]); o.z = pk2(s[4 * 33], s[5 * 33]); o.w = pk2(s[6 * 33], s[7 * 33]);
        *(GAS v4u*)(d.dst + (size_t)(n0 + n) * d.K + k0 + 8 * c) = o; }
    asm volatile("s_waitcnt lgkmcnt(0)" ::: "memory");
}
__device__ __forceinline__ void convert_mat(const MatDesc d, LAS unsigned char* lds, int gw, int NGW, int wave, int lane) {
    LAS float* scr = (LAS float*)(lds + wave * 16384); const int nitems = (d.K / 64) * (d.nrows / 32);
#pragma unroll 1
    for (int it = gw; it < nitems; it += NGW) transpose_item(d, scr, it, lane);
}

constexpr size_t WS_FTAB = 4 * MiB;
constexpr size_t WS_MTAB = 253 * MiB;
__device__ __forceinline__ void conv_item(int item, bf16* P, const float* conv_w, const float* conv_b, int tid) {
    const int b = item >> 5, cgp = item & 31, cc = tid & 7, seg = tid >> 3;
    const int ch0 = 64 * cgp + 8 * cc, slot = ch0 >> 10, col = ch0 & 1023; const float osc = slot ? 0.0625f : 1.0f;
    bf16* base = P + (size_t)slot * M * D + ((size_t)b * T + 32 * seg) * D + col;
    float w0[8], w1[8], w2[8], w3[8], bb[8];
#pragma unroll
    for (int e = 0; e < 8; ++e) { w0[e] = conv_w[ch0 + e]; w1[e] = conv_w[2048 + ch0 + e]; w2[e] = conv_w[4096 + ch0 + e]; w3[e] = conv_w[6144 + ch0 + e]; bb[e] = conv_b[ch0 + e]; }
    v4u h0 = {0u, 0u, 0u, 0u}, h1 = h0, h2 = h0;
    if (seg > 0) { h0 = *(const v4u*)(base - 3 * D); h1 = *(const v4u*)(base - 2 * D); h2 = *(const v4u*)(base - 1 * D); }
    asm volatile("s_waitcnt vmcnt(0)" ::: "memory");
    __syncthreads();
#pragma unroll 4
    for (int r = 0; r < 32; ++r) { const v4u cur = *(const v4u*)(base + (size_t)r * D); v4u o;
#pragma unroll
        for (int e2 = 0; e2 < 4; ++e2) { const int e = 2 * e2;
            float ya = bb[e] + w0[e] * pg8::bf_lo(h0[e2]) + w1[e] * pg8::bf_lo(h1[e2]) + w2[e] * pg8::bf_lo(h2[e2]) + w3[e] * pg8::bf_lo(cur[e2]);
            float yb = bb[e + 1] + w0[e + 1] * pg8::bf_hi(h0[e2]) + w1[e + 1] * pg8::bf_hi(h1[e2]) + w2[e + 1] * pg8::bf_hi(h2[e2]) + w3[e + 1] * pg8::bf_hi(cur[e2]);
            ya = ya * pg8::sigm(ya) * osc; yb = yb * pg8::sigm(yb) * osc; o[e2] = pk2(ya, yb); }
        *(v4u*)(base + (size_t)r * D) = o; h0 = h1; h1 = h2; h2 = cur; }
    __syncthreads();
}
__device__ __forceinline__ void ftab_item(int bh, const float* gates, v4u* ftab, LAS float* wt, int tid, int lane, int wave) {
    const int b = bh >> 4, h = bh & 15;
    float vv[4]; float s = 0.f;
#pragma unroll
    for (int i = 0; i < 4; ++i) { vv[i] = log_sigmoid(gates[((size_t)b * T + 4 * tid + i) * 32 + 8 + h]); s += vv[i]; vv[i] = s; }
    float x = s;
#pragma unroll
    for (int o = 1; o < 64; o <<= 1) { const float y = __shfl_up(x, o); if (lane >= o) x += y; }
    if (lane == 63) wt[wave] = x;
    __syncthreads();
    float off = 0.f;
#pragma unroll
    for (int k = 0; k < NWAVES; ++k) { const float t_ = wt[k]; if (k < wave) off += t_; }
    const float base = off + x - s;
#pragma unroll
    for (int i = 0; i < 4; ++i) { const float xb = -(vv[i] + base) * 1.4426950408889634f;
        const unsigned h0 = f2bf(xb); const float r0 = xb - __uint_as_float(h0 << 16); const unsigned m0 = f2bf(r0); const float q0 = r0 - __uint_as_float(m0 << 16); const unsigned l0 = f2bf(q0);
        v4u o4; o4.x = h0 | (m0 << 16); o4.y = l0 | 0x3f800000u; o4.z = 0x3f803f80u; o4.w = 0u;
        ftab[(size_t)bh * T + 4 * tid + i] = o4; }
    __syncthreads();
}
__device__ __forceinline__ void mtab_item(int bh, const float* gates, float* mtab, int lane) {
    const int b = bh >> 2, h = bh & 3; float mprev = 0.f; float* mt = mtab + (size_t)bh * 5 * T;
    float liv[32], lfv[32];
#pragma unroll
    for (int c = 0; c < 32; ++c) { const size_t row = (size_t)b * T + c * 64 + lane; liv[c] = gates[row * 32 + h]; lfv[c] = gates[row * 32 + 4 + h]; }
#pragma unroll
    for (int c = 0; c < 32; ++c) { const int t = c * 64 + lane;
        const float li = liv[c], lf = log_sigmoid(lfv[c]);
        float bc = lf;
#pragma unroll
        for (int o = 1; o < 64; o <<= 1) { const float y = __shfl_up(bc, o); if (lane >= o) bc += y; }
        const float a = li - bc; float cm = a;
#pragma unroll
        for (int o = 1; o < 64; o <<= 1) { const float y = __shfl_up(cm, o); if (lane >= o) cm = fmaxf(cm, y); }
        const float r = fmaxf(mprev, cm), r63 = __shfl(r, 63), b63 = __shfl(bc, 63);
        mt[t] = a * 1.4426950408889634f; mt[T + t] = r * 1.4426950408889634f; mt[2 * T + t] = expf(mprev - r); mt[3 * T + t] = expf(-(bc + r)); mt[4 * T + t] = expf(a - r63);
        mprev = b63 + r63; }
}

#define RLX_AGENT __ATOMIC_RELAXED, __HIP_MEMORY_SCOPE_AGENT
#define XB_TMO      128
#define XB_XCNT(j)  (256  + 64 * (j))
#define XB_XSUB(j)  (1280 + 64 * (j))
#define XB_XGEN(j)  (2304 + 64 * (j))
#define XB_TOP      3328
#define XB_TOPGEN   3392
#define XCD_BAR_WORDS 3456
#define XB_SPIN_CAP (1u << 18)

__device__ __forceinline__ unsigned xb_ld(unsigned* p)              { return __hip_atomic_load(p, __ATOMIC_RELAXED, __HIP_MEMORY_SCOPE_AGENT); }
__device__ __forceinline__ unsigned xb_add(unsigned* p, unsigned v) { return __hip_atomic_fetch_add(p, v, __ATOMIC_RELAXED, __HIP_MEMORY_SCOPE_AGENT); }
__device__ __forceinline__ unsigned xb_xcc_id() { return (unsigned)__builtin_amdgcn_s_getreg((3 << 11) | 20) & 0xFu; }
#define XB_SPIN(cond, bar) do { unsigned _sp = 0; while (cond) { __builtin_amdgcn_s_sleep(1); \
    if ((++_sp & 255u) == 0u) { if (xb_ld(&(bar)[XB_TMO])) break; if (_sp > XB_SPIN_CAP) { atomicAdd(&(bar)[XB_TMO], 1u); break; } } } } while (0)

struct XcdBarrier {
    unsigned* bar; unsigned x;
    volatile LAS unsigned* st;
};

__device__ __forceinline__ XcdBarrier xcd_barrier_post(unsigned* bar, volatile LAS unsigned* st) {
    XcdBarrier b; b.bar = bar; b.x = xb_xcc_id(); b.st = st;
    if (threadIdx.x == 0) (void)xb_add(&bar[XB_XCNT(b.x)], 1u);
    return b;
}
__device__ __forceinline__ void xcd_barrier_complete(unsigned* bar, unsigned x, unsigned& nloc, unsigned& nx) {
    const unsigned G = gridDim.x * gridDim.y * gridDim.z;
    unsigned sum, cnt, mine, sp = 0u;
    for (;;) {
        sum = 0u; cnt = 0u; mine = 0u;
#pragma unroll
        for (unsigned j = 0; j < 16; ++j) { const unsigned c = xb_ld(&bar[XB_XCNT(j)]); sum += c; cnt += (c > 0u) ? 1u : 0u; mine = (j == x) ? c : mine; }
        if (sum == G) break;
        __builtin_amdgcn_s_sleep(1);
        if ((++sp & 255u) == 0u) { if (xb_ld(&bar[XB_TMO])) break; if (sp > XB_SPIN_CAP) { atomicAdd(&bar[XB_TMO], 1u); break; } }
    }
    nloc = mine > 0u ? mine : 1u; nx = cnt > 0u ? cnt : 1u;
}

__device__ __forceinline__ void xcd_barrier(const XcdBarrier& b) {
    asm volatile("s_waitcnt vmcnt(0)" ::: "memory");
    __syncthreads();
    if (threadIdx.x == 0) {
        unsigned* bar = b.bar;
        __builtin_amdgcn_s_waitcnt(0);
        unsigned nloc = b.st[0], nx = b.st[1];
        if (nloc == 0u) { xcd_barrier_complete(bar, b.x, nloc, nx); b.st[0] = nloc; b.st[1] = nx; }
        const unsigned old = xb_add(&bar[XB_XSUB(b.x)], 1u);
        const unsigned gen = old / nloc;
        if (old + 1u == (gen + 1u) * nloc) {
            __builtin_amdgcn_fence(__ATOMIC_RELEASE, "agent");
            asm volatile("s_waitcnt vmcnt(0)" ::: "memory");
            const unsigned og = xb_add(&bar[XB_TOP], 1u);
            const unsigned tg = og / nx;
            if (og + 1u == (tg + 1u) * nx) xb_add(&bar[XB_TOPGEN], 1u);
            else XB_SPIN(xb_ld(&bar[XB_TOPGEN]) == tg, bar);
            __builtin_amdgcn_fence(__ATOMIC_ACQUIRE, "agent");
            xb_add(&bar[XB_XGEN(b.x)], 1u);
            asm volatile("s_waitcnt vmcnt(0)" ::: "memory");
        } else {
            XB_SPIN(xb_ld(&bar[XB_XGEN(b.x)]) == gen, bar);
            __builtin_amdgcn_fence(__ATOMIC_ACQUIRE, "agent");
            asm volatile("s_waitcnt vmcnt(0)" ::: "memory");
        }
    }
    __syncthreads();
}

__global__ void __launch_bounds__(NWAVES * 64, 2) mk_fwd(Args args) {
    __builtin_assume(__builtin_amdgcn_workitem_id_y() == 0); __builtin_assume(__builtin_amdgcn_workitem_id_z() == 0);
    extern __shared__ __attribute__((aligned(16))) unsigned char lds_raw[];
    LAS unsigned char* lds = (LAS unsigned char*)lds_raw;
    const int tid = threadIdx.x, lane = tid & 63, wave = __builtin_amdgcn_readfirstlane(tid >> 6);
    const int G = gridDim.x, gw = blockIdx.x * NWAVES + wave, NGW = G * NWAVES;
    unsigned char* ws = args.ws;
    float* ctlf = (float*)(ws + WS_CTL);
    float* SS0 = (float*)(ws + CTL_SS * 1); float* SS1 = (float*)(ws + CTL_SS * 2); float* SS2 = (float*)(ws + CTL_SS * 3); float* SS3 = (float*)(ws + CTL_SS * 4);
    float* STATS = (float*)(ws + CTL_STATS);
    float* BIASA = (float*)(ws + WS_BIASA); float* BIASB = (float*)(ws + WS_BIASB); float* GATES = (float*)(ws + WS_GATES);
    bf16* XB = (bf16*)(ws + WS_XB); bf16* P = (bf16*)(ws + WS_P);
    const int lo = args.ph_lo, hi = args.ph_hi;
    volatile LAS unsigned* xst = (volatile LAS unsigned*)(lds + LDS_BYTES - 64);
    if (tid < 2) xst[tid] = 0u;
    __syncthreads();
    for (int i = blockIdx.x * (NWAVES * 64) + tid; i < (int)(CTL_ZERO_BYTES / 4); i += G * (NWAVES * 64)) ((unsigned*)(ws + WS_CTL))[i] = 0u;
    cooperative_groups::this_grid().sync();
    XcdBarrier xbar = xcd_barrier_post((unsigned*)(ws + WS_CTL) + 8192 + (args.coop > 1 ? XCD_BAR_WORDS : 0), xst);
#define IN(k) (lo <= (k) && (k) < hi)
#define SEAM(k) do { if (IN(k) && IN((k) + 1)) { xcd_barrier(xbar); } } while (0)
    (void)ctlf;
    if (IN(0)) {
        convert_mat(MatDesc{args.in[2], args.in[3], args.in[1], (bf16*)(ws + WS_W1GU), D, FF, 2 * FF, 0}, lds, gw, NGW, wave, lane);
        if (G <= BATCH * NHF) convert_mat(MatDesc{args.in[6], nullptr, args.in[5], (bf16*)(ws + WS_WINB), D, 9240, NB, 3}, lds, gw, NGW, wave, lane);
        for (int c = blockIdx.x * 512 + tid; c < NAC + NB; c += G * 512) {
            if (c < NAC) { const int s = inA_src(c); BIASA[c] = s < 0 ? 0.f : args.in[7][s]; } else { const int s = inB_src(c - NAC); BIASB[c - NAC] = s < 0 ? 0.f : args.in[7][s]; } }
        for (int m0 = gw; m0 < M; m0 += 4 * NGW) {
            f32x4 v[4][4];
#pragma unroll
            for (int r = 0; r < 4; ++r) { const int m = m0 + r * NGW; if (m < M) { const GAS f32x4* xr = (const GAS f32x4*)(args.in[0] + (size_t)m * D) + lane;
#pragma unroll
                for (int j = 0; j < 4; ++j) v[r][j] = xr[64 * j]; } }
#pragma unroll
            for (int r = 0; r < 4; ++r) { const int m = m0 + r * NGW; if (m < M) { GAS unsigned long long* o8 = (GAS unsigned long long*)(XB + (size_t)m * D) + lane; float s = 0.f;
#pragma unroll
                for (int j = 0; j < 4; ++j) { const f32x4 t = v[r][j]; s += (t.x * t.x + t.y * t.y) + (t.z * t.z + t.w * t.w); o8[64 * j] = (unsigned long long)pk2(t.x, t.y) | ((unsigned long long)pk2(t.z, t.w) << 32); }
                s = wave_sum(s); if (lane == 0) SS0[m] = s; } } }
    }
    SEAM(0);
    if (IN(1)) { pg8::Gemm g{XB, (const bf16*)(ws + WS_W1GU), M, 2 * FF, D}; pg8::StaticOrder S; S.init(M, 2 * FF, G, (int)blockIdx.x);
        pg8::EpiSwiGLU E{(bf16*)(ws + WS_H1), FF, SS0};
        pg8::gemm_phase<pg8::EpiSwiGLU, pg8::StaticOrder, true, true>(lds, g, S, E);
        { const int rem = ((M / 256) * (2 * FF / 256)) % G, fb = rem == 0 ? 0 : rem;
          if ((int)blockIdx.x >= fb) { const int gw2 = ((int)blockIdx.x - fb) * NWAVES + wave, ngw2 = (G - fb) * NWAVES;
              convert_mat(MatDesc{args.in[4], nullptr, nullptr, (bf16*)(ws + WS_W1D), FF, D, D, 1}, lds, gw2, ngw2, wave, lane);
              convert_mat(MatDesc{args.in[6], nullptr, args.in[5], (bf16*)(ws + WS_WINA), D, 9240, NAC, 2}, lds, gw2, ngw2, wave, lane); } } }
    SEAM(1);
    if (IN(2)) { pg8::Gemm g{(const bf16*)(ws + WS_H1), (const bf16*)(ws + WS_W1D), M, D, FF}; pg8::StaticOrder S; S.init(M, D, G, (int)blockIdx.x);
        pg8::EpiResid E{args.in[0], args.out, XB, SS1, 0.5f};
        pg8::gemm_phase<pg8::EpiResid, pg8::StaticOrder, true, true>(lds, g, S, E); }
    SEAM(2);
    if (IN(3)) {
        { typedef short bf16x8_t __attribute__((ext_vector_type(8))); const int c16 = lane & 15, gq = lane >> 4, cb = wave >> 2, col = 16 * cb + c16;
            const bf16* wrow = (const bf16*)(ws + WS_WINA) + (size_t)(6144 + col) * D + 8 * gq;
#pragma unroll 1
            for (int item = blockIdx.x * 4 + (wave & 3); item < M / 16; item += G * 4) { const bf16* xr = XB + (size_t)(item * 16 + c16) * D + 8 * gq;
                bf16x8_t a[32];
#pragma unroll
                for (int j = 0; j < 32; ++j) a[j] = *(const bf16x8_t*)(xr + 32 * j);
                f32x4 acc0 = {0.f, 0.f, 0.f, 0.f};
#pragma unroll
                for (int jb = 0; jb < 2; ++jb) { bf16x8_t b0[16];
#pragma unroll
                    for (int j = 0; j < 16; ++j) b0[j] = *(const bf16x8_t*)(wrow + 32 * (16 * jb + j));
#pragma unroll
                    for (int j = 0; j < 16; ++j) acc0 = __builtin_amdgcn_mfma_f32_16x16x32_bf16(a[16 * jb + j], b0[j], acc0, 0, 0, 0); }
                const float bc0 = BIASA[6144 + col];
                if (col < 24) {
#pragma unroll
                    for (int i = 0; i < 4; ++i) { const int r = item * 16 + 4 * gq + i; const float rs = __builtin_amdgcn_rsqf(SS1[r] * (1.f / D) + 1e-6f);
                        GATES[(size_t)r * 32 + col] = acc0[i] * rs + bc0; } } } }
        pg8::Gemm g{XB, (const bf16*)(ws + WS_WINA), M, NA, D}; pg8::StaticOrder S; S.init(M, NA, G, (int)blockIdx.x);
        pg8::EpiInA E{P, (size_t)M * D, GATES, BIASA, SS1, C2};
        pg8::gemm_phase<pg8::EpiInA, pg8::StaticOrder, true, true>(lds, g, S, E); }
    SEAM(3);
    if (IN(4)) {
#pragma unroll 1
        for (int it = blockIdx.x; it < BATCH * 32; it += G) conv_item(it, P, args.in[8], args.in[9], tid);
#pragma unroll 1
        for (int it = blockIdx.x; it < BATCH * NHF; it += G) ftab_item(it, GATES, (v4u*)(ws + WS_FTAB), (LAS float*)lds, tid, lane, wave);
#pragma unroll 1
        for (int it = blockIdx.x; it < BATCH * NHM; it += G) if (wave == NWAVES - 1) mtab_item(it, GATES, (float*)(ws + WS_MTAB), lane);
        { const int fb = G > BATCH * NHF ? BATCH * NHF : 0;
          if (fb && (int)blockIdx.x >= BATCH * NHM && (int)blockIdx.x < fb)
              convert_mat(MatDesc{args.in[6], nullptr, args.in[5], (bf16*)(ws + WS_WINB), D, 9240, NB, 3}, lds, ((int)blockIdx.x - BATCH * NHM) * NWAVES + wave, (fb - BATCH * NHM) * NWAVES, wave, lane);
          if ((int)blockIdx.x >= fb) { const int gw2 = ((int)blockIdx.x - fb) * NWAVES + wave, ngw2 = (G - fb) * NWAVES;
              convert_mat(MatDesc{args.in[13], args.in[14], args.in[12], (bf16*)(ws + WS_W2GU), D, FF, 2 * FF, 0}, lds, gw2, ngw2, wave, lane);
              convert_mat(MatDesc{args.in[11], nullptr, nullptr, (bf16*)(ws + WS_WOUT), D, D, D, 1}, lds, gw2, ngw2, wave, lane); } }
    }
    SEAM(4);
    if (IN(5)) {
#pragma unroll 1
        for (int x = blockIdx.x; x < ((args.mode & 1) ? 0 : 128); x += G) { const int pr = ((x >> 3) >> 2) + 4 * (x & 7), vs = (x >> 3) & 3;
            mls::mlstm_unit(pr >> 2, pr & 3, vs, P, P + (size_t)M * D, P + 2 * (size_t)M * D, (const float*)(ws + WS_MTAB), STATS, lds, args.mode); }
        const attn_body::bf16* Qp = (const attn_body::bf16*)(P + 3 * (size_t)M * D); const attn_body::bf16* Kp = (const attn_body::bf16*)(P + 4 * (size_t)M * D); const attn_body::bf16* Vp = (const attn_body::bf16*)(P + 5 * (size_t)M * D);
        volatile LAS unsigned* qslot = (volatile LAS unsigned*)(lds + attn_body::ATTN_LDS_BYTES);
        int qsel = 0;
#pragma unroll 1
        for (;;) {
            if (args.mode & 2) break;
            const int xq = ((int)blockIdx.x + qsel) & 7;
            if (tid == 0) *qslot = atomicAdd((unsigned*)(ws + WS_CTL) + 64 * xq, 1u);
            __syncthreads();
            const unsigned idx = *qslot;
            __syncthreads();
            if (idx >= 128u) { if (++qsel == 8) break; continue; }
            const int i2 = (int)(idx & 63u), qb = (idx < 64u ? 7 : 3) - (i2 & 3), bh = (i2 >> 2) * 8 + xq, b = bh >> 4, h = bh & 15;
            { int tid_ = tid; asm volatile("" : "+v"(tid_));
              const v4u* src = (const v4u*)(ws + WS_FTAB) + (size_t)bh * T; LAS v4u* dst = (LAS v4u*)(lds + attn_body::LDS_CB);
              const int ne = 256 * (qb + 1); v4u tb[4];
#pragma unroll
              for (int k = 0; k < 4; ++k) { const int e = tid_ + k * NWAVES * 64; if (e < ne) tb[k] = src[e]; }
#pragma unroll
              for (int k = 0; k < 4; ++k) { const int e = tid_ + k * NWAVES * 64; if (e < ne) dst[e] = tb[k]; } }
            __syncthreads();
            attn_body::attn_unit<56>(b, h, qb, Qp, Kp, Vp, (attn_body::bf16*)Qp, (char*)lds_raw);
        }
    }
    SEAM(5);
    if (IN(6)) {
        pg8::Gemm g{XB, (const bf16*)(ws + WS_WINB), M, NB, D}; pg8::StaticOrder S; S.init(M, NB, G, (int)blockIdx.x);
        pg8::EpiInB E{P + 2 * (size_t)M * D, P + 3 * (size_t)M * D, STATS, args.in[10], BIASB, SS1, (bf16*)(ws + WS_Y)};
        pg8::gemm_phase<pg8::EpiInB, pg8::StaticOrder, true, true>(lds, g, S, E); }
    SEAM(6);
    if (IN(7)) { pg8::Gemm g{(const bf16*)(ws + WS_Y), (const bf16*)(ws + WS_WOUT), M, D, D}; pg8::StaticOrder S; S.init(M, D, G, (int)blockIdx.x);
        pg8::EpiResid E{args.out, args.out, XB, SS2, 1.0f};
        pg8::gemm_phase<pg8::EpiResid, pg8::StaticOrder, true, true>(lds, g, S, E); }
    SEAM(7);
    if (IN(8)) { pg8::Gemm g{XB, (const bf16*)(ws + WS_W2GU), M, 2 * FF, D}; pg8::StaticOrder S; S.init(M, 2 * FF, G, (int)blockIdx.x);
        pg8::EpiSwiGLU E{(bf16*)(ws + WS_H2), FF, SS2};
        pg8::gemm_phase<pg8::EpiSwiGLU, pg8::StaticOrder, true, true>(lds, g, S, E);
        { const int rem = ((M / 256) * (2 * FF / 256)) % G, fb = rem == 0 ? 0 : rem;
          if ((int)blockIdx.x >= fb) convert_mat(MatDesc{args.in[15], nullptr, nullptr, (bf16*)(ws + WS_W2D), FF, D, D, 1}, lds, ((int)blockIdx.x - fb) * NWAVES + wave, (G - fb) * NWAVES, wave, lane); } }
    SEAM(8);
    if (IN(9)) { pg8::Gemm g{(const bf16*)(ws + WS_H2), (const bf16*)(ws + WS_W2D), M, D, FF}; pg8::StaticOrder S; S.init(M, D, G, (int)blockIdx.x);
        pg8::EpiResidNorm E{args.out, args.out, SS3, (unsigned*)(ws + WS_CTL) + 2048, args.in[16], 0.5f};
        pg8::gemm_phase<pg8::EpiResidNorm, pg8::StaticOrder, true, true>(lds, g, S, E); }
#undef IN
#undef SEAM
}

extern "C" void kernel_launch(void* const* d_in, const int* in_sizes, int n_in, void* d_out, int out_size, void* d_ws, size_t ws_size, hipStream_t stream) {
    static int ready = 0;
    if (!ready) { if (hipFuncSetAttribute((const void*)mk_fwd, hipFuncAttributeMaxDynamicSharedMemorySize, LDS_BYTES) != hipSuccess) { fprintf(stderr, "hipFuncSetAttribute failed\n"); } ready = 1; }
    if (n_in != 17 || ws_size < WS_END) { fprintf(stderr, "kernel_launch: unexpected n_in %d / ws %zu\n", n_in, ws_size); return; }
    Args a{};
    for (int i = 0; i < 17; ++i) a.in[i] = (const float*)d_in[i];
    a.out = (float*)d_out; a.ws = (unsigned char*)d_ws; a.coop = 0;
    static int grid = 0;
    if (!grid) { int dev = 0, cus = 0, per_cu = 0; hipGetDevice(&dev); hipDeviceGetAttribute(&cus, hipDeviceAttributeMultiprocessorCount, dev);
        hipOccupancyMaxActiveBlocksPerMultiprocessor(&per_cu, (const void*)mk_fwd, NWAVES * 64, LDS_BYTES);
        grid = cus * (per_cu < 1 ? 1 : 1); if (per_cu < 1) fprintf(stderr, "occupancy query says %d blocks/CU\n", per_cu); }
    void* kargs[] = {&a};
#if PROBE_K >= 0
    a.ph_lo = 0; a.ph_hi = PROBE_K + 1; a.coop = 2; a.mode = PROBE_MODE;
    (void)hipLaunchCooperativeKernel((const void*)mk_fwd, dim3(grid), dim3(NWAVES * 64), kargs, LDS_BYTES, stream);
#endif
    a.ph_lo = 0; a.ph_hi = 11; a.coop = 1; a.mode = 0;
    hipError_t e = hipLaunchCooperativeKernel((const void*)mk_fwd, dim3(grid), dim3(NWAVES * 64), kargs, LDS_BYTES, stream);
    if (e != hipSuccess) fprintf(stderr, "cooperative launch failed: %s (grid %d)\n", hipGetErrorString(e), grid);
}
```

```cpp
#include <hip/hip_runtime.h>
#include <hip/hip_cooperative_groups.h>
#include <hip/hip_bf16.h>
#include <cstdio>
#include <cstdint>
#include <cmath>
namespace pg8 {
#define PG8_LAS __attribute__((address_space(3)))
typedef unsigned short bf16_t;
typedef short bf16x8 __attribute__((ext_vector_type(8)));
typedef float f32x4 __attribute__((ext_vector_type(4)));
typedef unsigned u32x4 __attribute__((ext_vector_type(4)));
constexpr int BM = 256, BK = 64, HALF = 128, HTB = HALF * BK * 2  , STAGE_BYTES = 8 * HTB, NXCD = 8, WGM = 8;

__host__ __device__ __forceinline__ int lds_byte(int r, int c) { const int st = (r >> 4) * 2 + (c >> 5), rr = r & 15, cc = c & 31, ob = rr * 64 + cc * 2; return st * 1024 + (ob ^ (((ob >> 9) & 1) << 5)); }
__host__ __device__ __forceinline__ void stage_rc(int b, int& R, int& C) { const int st = b / 1024, sb = b % 1024, swz = sb ^ (((sb >> 9) & 1) << 5); R = (st >> 1) * 16 + swz / 64; C = (st & 1) * 32 + (swz % 64) / 2; }
__host__ __device__ __forceinline__ int perm32(int rho) { const int n = rho >> 4, i = rho & 15; return 8 * (i >> 2) + 4 * n + (i & 3); }

struct Unit { int pm, pn; };
struct Gemm { const bf16_t* A; const bf16_t* Bt; int M, N, K; };

struct StaticOrder {
    int nM, nN, nwg, G, c;
    __host__ __device__ void init(int M, int N, int G_, int c_) { nM = M / BM; nN = N / BM; nwg = nM * nN; G = G_; c = c_; }
    __host__ __device__ bool next(int i, Unit& u) const {
        const long L = (long)i * G + c; if (L >= nwg) return false;
        int wgid = (int)L; { const int q = nwg / NXCD, r = nwg % NXCD, xcd = wgid % NXCD, off = wgid / NXCD; wgid = (xcd < r ? xcd * (q + 1) : r * (q + 1) + (xcd - r) * q) + off; }
        const int nig = WGM * nN, gid = wgid / nig, fm = gid * WGM, gsz = (nM - fm) < WGM ? (nM - fm) : WGM;
        u.pm = fm + ((wgid % nig) % gsz); u.pn = (wgid % nig) / gsz; return true;
    }
    __device__ __forceinline__ void a_ready(const Unit&) const {}
    __device__ __forceinline__ void done(const Unit&) const {}
};

__device__ __forceinline__ unsigned cvt_pk_bf16(float lo, float hi) { unsigned r; asm volatile("v_cvt_pk_bf16_f32 %0, %1, %2" : "=v"(r) : "v"(lo), "v"(hi)); return r; }
typedef float f32x2 __attribute__((ext_vector_type(2)));
typedef unsigned u32x2 __attribute__((ext_vector_type(2)));
constexpr float RMS_EPS = 1e-6f, INV_D = 1.0f / 1024.0f, LOG2E = 1.4426950408889634f;
__device__ __forceinline__ float sigm(float x) { return __builtin_amdgcn_rcpf(1.f + __builtin_amdgcn_exp2f(-LOG2E * x)); }
__device__ __forceinline__ float bf_lo(unsigned w) { return __uint_as_float(w << 16); }
__device__ __forceinline__ float bf_hi(unsigned w) { return __uint_as_float(w & 0xffff0000u); }

struct EpiSwiGLU {
    static constexpr bool PERM = true, AFTER_DRAIN = false;
    bf16_t* H; int ldh; const float* ss;
    __device__ __forceinline__ void operator()(const f32x4 (&acc)[2][2][4][2], const Unit& u, int wr, int wc, int fr, int fq) const {
        const int row0 = u.pm * BM + wr * 64 + fr, col0 = u.pn * 128 + wc * 32 + 8 * fq;
        float rsv[2][4];
#pragma unroll
        for (int ai = 0; ai < 2; ++ai)
#pragma unroll
            for (int m = 0; m < 4; ++m) rsv[ai][m] = ss[row0 + ai * HALF + m * 16];
#pragma unroll
        for (int ai = 0; ai < 2; ++ai)
#pragma unroll
            for (int m = 0; m < 4; ++m) { const int row = row0 + ai * HALF + m * 16; const float rs = __builtin_amdgcn_rsqf(rsv[ai][m] * INV_D + RMS_EPS);
                const f32x4 g0 = acc[ai][0][m][0] * rs, g1 = acc[ai][0][m][1] * rs, p0 = acc[ai][1][m][0] * rs, p1 = acc[ai][1][m][1] * rs;
                u32x4 w;
                w.x = cvt_pk_bf16(g0[0] * sigm(g0[0]) * p0[0], g0[1] * sigm(g0[1]) * p0[1]); w.y = cvt_pk_bf16(g0[2] * sigm(g0[2]) * p0[2], g0[3] * sigm(g0[3]) * p0[3]);
                w.z = cvt_pk_bf16(g1[0] * sigm(g1[0]) * p1[0], g1[1] * sigm(g1[1]) * p1[1]); w.w = cvt_pk_bf16(g1[2] * sigm(g1[2]) * p1[2], g1[3] * sigm(g1[3]) * p1[3]);
                *(u32x4*)(H + (size_t)row * ldh + col0) = w; }
    }
};

struct EpiResid {
    static constexpr bool PERM = true, AFTER_DRAIN = false;
    const float* base; float* out; bf16_t* xb; float* ssout; float alpha;
    __device__ __forceinline__ void operator()(const f32x4 (&acc)[2][2][4][2], const Unit& u, int wr, int wc, int fr, int fq) const {
        const int row0 = u.pm * BM + wr * 64 + fr, col0 = u.pn * BM + wc * 32 + 8 * fq;
#pragma unroll
        for (int ai = 0; ai < 2; ++ai) {
            f32x4 bs[4][2][2];
#pragma unroll
            for (int m = 0; m < 4; ++m)
#pragma unroll
                for (int bj = 0; bj < 2; ++bj) { const size_t off = (size_t)(row0 + ai * HALF + m * 16) * 1024 + col0 + bj * HALF; bs[m][bj][0] = *(const f32x4*)(base + off); bs[m][bj][1] = *(const f32x4*)(base + off + 4); }
#pragma unroll
            for (int m = 0; m < 4; ++m) { const int row = row0 + ai * HALF + m * 16; float q = 0.f;
#pragma unroll
                for (int bj = 0; bj < 2; ++bj) { const size_t off = (size_t)row * 1024 + col0 + bj * HALF;
                    const f32x4 o0 = bs[m][bj][0] + acc[ai][bj][m][0] * alpha, o1 = bs[m][bj][1] + acc[ai][bj][m][1] * alpha;
                    *(f32x4*)(out + off) = o0; *(f32x4*)(out + off + 4) = o1;
                    if (xb) { u32x4 w; w.x = cvt_pk_bf16(o0[0], o0[1]); w.y = cvt_pk_bf16(o0[2], o0[3]); w.z = cvt_pk_bf16(o1[0], o1[1]); w.w = cvt_pk_bf16(o1[2], o1[3]); *(u32x4*)(xb + off) = w; }
                    q += (o0[0] * o0[0] + o0[1] * o0[1]) + (o0[2] * o0[2] + o0[3] * o0[3]) + (o1[0] * o1[0] + o1[1] * o1[1]) + (o1[2] * o1[2] + o1[3] * o1[3]); }
                q += __shfl_xor(q, 16); q += __shfl_xor(q, 32);
                if (fq == 0) unsafeAtomicAdd(ssout + row, q); }
            asm volatile("" ::: "memory"); }
    }
};

struct EpiResidNorm {
    static constexpr bool PERM = true, AFTER_DRAIN = false;
    const float* base; float* out; float* ss; unsigned* cnt; const float* gain; float alpha;
    __device__ __forceinline__ void operator()(const f32x4 (&acc_c)[2][2][4][2], const Unit& u, int wr, int wc, int fr, int fq) const {
        f32x4 (&acc)[2][2][4][2] = const_cast<f32x4 (&)[2][2][4][2]>(acc_c);
        const int row0 = u.pm * BM + wr * 64 + fr, col0 = u.pn * BM + wc * 32 + 8 * fq;
#pragma unroll
        for (int ai = 0; ai < 2; ++ai) {
            f32x4 bs[4][2][2];
#pragma unroll
            for (int m = 0; m < 4; ++m)
#pragma unroll
                for (int bj = 0; bj < 2; ++bj) { const size_t off = (size_t)(row0 + ai * HALF + m * 16) * 1024 + col0 + bj * HALF; bs[m][bj][0] = *(const f32x4*)(base + off); bs[m][bj][1] = *(const f32x4*)(base + off + 4); }
#pragma unroll
            for (int m = 0; m < 4; ++m) { const int row = row0 + ai * HALF + m * 16; float q = 0.f;
#pragma unroll
                for (int bj = 0; bj < 2; ++bj) { const f32x4 o0 = bs[m][bj][0] + acc[ai][bj][m][0] * alpha, o1 = bs[m][bj][1] + acc[ai][bj][m][1] * alpha;
                    acc[ai][bj][m][0] = o0; acc[ai][bj][m][1] = o1;
                    q += (o0[0] * o0[0] + o0[1] * o0[1]) + (o0[2] * o0[2] + o0[3] * o0[3]) + (o1[0] * o1[0] + o1[1] * o1[1]) + (o1[2] * o1[2] + o1[3] * o1[3]); }
                q += __shfl_xor(q, 16); q += __shfl_xor(q, 32);
                if (fq == 0) __hip_atomic_fetch_add(ss + row, q, __ATOMIC_RELAXED, __HIP_MEMORY_SCOPE_AGENT); }
            asm volatile("" ::: "memory"); }
        f32x4 gv[2][2];
#pragma unroll
        for (int bj = 0; bj < 2; ++bj) { gv[bj][0] = *(const f32x4*)(gain + col0 + bj * HALF); gv[bj][1] = *(const f32x4*)(gain + col0 + bj * HALF + 4); }
        asm volatile("s_waitcnt vmcnt(0)" ::: "memory");
        __builtin_amdgcn_fence(__ATOMIC_RELEASE, "agent");
        unsigned* c = cnt + 64 * u.pm;
        if (__builtin_amdgcn_readfirstlane((int)(threadIdx.x & 63)) == 0 || true) { if ((threadIdx.x & 63) == 0) __hip_atomic_fetch_add(c, 1u, __ATOMIC_RELAXED, __HIP_MEMORY_SCOPE_AGENT); }
        for (unsigned spin = 0; spin < (1u << 22); ++spin) { if (__hip_atomic_load(c, __ATOMIC_RELAXED, __HIP_MEMORY_SCOPE_AGENT) >= 32u) break; __builtin_amdgcn_s_sleep(2); }
        __builtin_amdgcn_fence(__ATOMIC_ACQUIRE, "agent");
#pragma unroll
        for (int ai = 0; ai < 2; ++ai)
#pragma unroll
            for (int m = 0; m < 4; ++m) { const int row = row0 + ai * HALF + m * 16;
                const float rs = __builtin_amdgcn_rsqf(__hip_atomic_load(ss + row, __ATOMIC_RELAXED, __HIP_MEMORY_SCOPE_AGENT) * INV_D + RMS_EPS);
#pragma unroll
                for (int bj = 0; bj < 2; ++bj) { const size_t off = (size_t)row * 1024 + col0 + bj * HALF;
                    *(f32x4*)(out + off) = acc[ai][bj][m][0] * rs * gv[bj][0]; *(f32x4*)(out + off + 4) = acc[ai][bj][m][1] * rs * gv[bj][1]; } }
    }
};

struct EpiInA {
    static constexpr bool PERM = true, AFTER_DRAIN = false;
    bf16_t* P; size_t slot_stride; float* gates; const float* bias; const float* ss; float qscale;
    __device__ __forceinline__ void operator()(const f32x4 (&acc)[2][2][4][2], const Unit& u, int wr, int wc, int fr, int fq) const {
        const int row0 = u.pm * BM + wr * 64 + fr, colt = u.pn * BM;
        if (colt >= 6144) {
            if (wc == 0) { const f32x4 bv0 = *(const f32x4*)(bias + colt + 8 * fq), bv1 = *(const f32x4*)(bias + colt + 8 * fq + 4);
#pragma unroll
                for (int ai = 0; ai < 2; ++ai)
#pragma unroll
                    for (int m = 0; m < 4; ++m) { const int row = row0 + ai * HALF + m * 16; const float rs = __builtin_amdgcn_rsqf(ss[row] * INV_D + RMS_EPS);
                        *(f32x4*)(gates + (size_t)row * 32 + 8 * fq) = acc[ai][0][m][0] * rs + bv0; *(f32x4*)(gates + (size_t)row * 32 + 8 * fq + 4) = acc[ai][0][m][1] * rs + bv1; } }
            return; }
        const int slot = colt >> 10, cb = (colt & 1023) + wc * 32 + 8 * fq; const float sc = (slot == 3) ? qscale : 1.f;
        bf16_t* O = P + (size_t)slot * slot_stride;
        f32x4 bv[2][2];
#pragma unroll
        for (int bj = 0; bj < 2; ++bj)
#pragma unroll
            for (int n = 0; n < 2; ++n) bv[bj][n] = *(const f32x4*)(bias + colt + bj * HALF + wc * 32 + 8 * fq + 4 * n);
        float rsv[2][4];
#pragma unroll
        for (int ai = 0; ai < 2; ++ai)
#pragma unroll
            for (int m = 0; m < 4; ++m) rsv[ai][m] = ss[row0 + ai * HALF + m * 16];
#pragma unroll
        for (int ai = 0; ai < 2; ++ai)
#pragma unroll
            for (int m = 0; m < 4; ++m) { const int row = row0 + ai * HALF + m * 16; const float rs = __builtin_amdgcn_rsqf(rsv[ai][m] * INV_D + RMS_EPS);
#pragma unroll
                for (int bj = 0; bj < 2; ++bj) { const f32x4 v0 = (acc[ai][bj][m][0] * rs + bv[bj][0]) * sc, v1 = (acc[ai][bj][m][1] * rs + bv[bj][1]) * sc;
                    u32x4 w; w.x = cvt_pk_bf16(v0[0], v0[1]); w.y = cvt_pk_bf16(v0[2], v0[3]); w.z = cvt_pk_bf16(v1[0], v1[1]); w.w = cvt_pk_bf16(v1[2], v1[3]);
                    *(u32x4*)(O + (size_t)row * 1024 + cb + bj * HALF) = w; } }
    }
};

struct EpiInB {
    static constexpr bool PERM = true, AFTER_DRAIN = false;
    const bf16_t* ha; const bf16_t* yb; const float* stats; const float* gn; const float* bias; const float* ss; bf16_t* Y;
    __device__ __forceinline__ void operator()(const f32x4 (&acc)[2][2][4][2], const Unit& u, int wr, int wc, int fr, int fq) const {
        const int row0 = u.pm * BM + wr * 64 + fr, j = u.pn * 64 + wc * 16 + 4 * fq, head = j >> 8, cb = u.pn * BM + wc * 32 + 8 * fq;
        const f32x4 bmo = *(const f32x4*)(bias + cb), bga = *(const f32x4*)(bias + cb + 4), bgb = *(const f32x4*)(bias + cb + HALF), gnv = *(const f32x4*)(gn + j);
        float rsv[2][4]; f32x2 stv[2][4]; u32x2 hwv[2][4], ywv[2][4];
#pragma unroll
        for (int ai = 0; ai < 2; ++ai)
#pragma unroll
            for (int m = 0; m < 4; ++m) { const int row = row0 + ai * HALF + m * 16; rsv[ai][m] = ss[row]; stv[ai][m] = *(const f32x2*)(stats + ((size_t)row * 4 + head) * 2);
                hwv[ai][m] = *(const u32x2*)(ha + (size_t)row * 1024 + j); ywv[ai][m] = *(const u32x2*)(yb + (size_t)row * 1024 + j); }
#pragma unroll
        for (int ai = 0; ai < 2; ++ai)
#pragma unroll
            for (int m = 0; m < 4; ++m) { const int row = row0 + ai * HALF + m * 16; const float rs = __builtin_amdgcn_rsqf(rsv[ai][m] * INV_D + RMS_EPS);
                const f32x4 mo = acc[ai][0][m][0] * rs + bmo, ga = acc[ai][0][m][1] * rs + bga, gb = acc[ai][1][m][0] * rs + bgb;
                const float s1 = stv[ai][m].x, s2 = stv[ai][m].y;
                const float mean = s1 * (1.f / 256.f), var = fmaxf(s2 * (1.f / 256.f) - mean * mean, 0.f), rln = __builtin_amdgcn_rsqf(var + RMS_EPS);
                const u32x2 hw = hwv[ai][m], yw = ywv[ai][m];
                const f32x4 hv = {bf_lo(hw.x), bf_hi(hw.x), bf_lo(hw.y), bf_hi(hw.y)}, yv = {bf_lo(yw.x), bf_hi(yw.x), bf_lo(yw.y), bf_hi(yw.y)};
                f32x4 y;
#pragma unroll
                for (int i = 0; i < 4; ++i) y[i] = sigm(ga[i]) * sigm(mo[i]) * ((hv[i] - mean) * rln * gnv[i]) + sigm(gb[i]) * yv[i];
                u32x2 w; w.x = cvt_pk_bf16(y[0], y[1]); w.y = cvt_pk_bf16(y[2], y[3]);
                *(u32x2*)(Y + (size_t)row * 1024 + j) = w; }
    }
};

template <class Epi, class Sched, bool ALIGN_EPI = false, bool SP2 = false>
__device__ __forceinline__ void gemm_phase(PG8_LAS unsigned char* lds, const Gemm g, const Sched& S, const Epi& E) {
    const int tid = threadIdx.x, wid = __builtin_amdgcn_readfirstlane(tid >> 6), lane = tid & 63, wr = wid >> 2, wc = wid & 3, fr = lane & 15, fq = lane >> 4;
    const int K = g.K, nt = K / BK;
    unsigned voffA[2], voffB[2];
#pragma unroll
    for (int i = 0; i < 2; ++i) { int R, C; stage_rc(tid * 16 + i * 8192, R, C); const int Rb = Epi::PERM ? ((R & ~31) + perm32(R & 31)) : R;
        voffA[i] = (unsigned)(R * K + C) * 2u; voffB[i] = (unsigned)(Rb * K + C) * 2u; }
    const size_t kstep = (size_t)(BK * 2);
    const size_t hstep = (size_t)HALF * K * 2;
    const size_t tstep = 2 * hstep;
    const unsigned ldsw = (unsigned)wid * 1024u;
    const int aoff = lds_byte(wr * 64 + fr, fq * 8), boff = lds_byte(wc * 32 + fr, fq * 8);
#define PG8_SA(b, h) (((b) * 2 + (h)) * HTB)
#define PG8_SB(b, h) ((4 + (b) * 2 + (h)) * HTB)
#define PG8_STAGE(bufoff, gbase, voff) do { _Pragma("unroll") for (int _i = 0; _i < 2; ++_i) \
        __builtin_amdgcn_global_load_lds((const unsigned*)((const char*)(gbase) + (voff)[_i]), (PG8_LAS unsigned*)(lds + (bufoff) + ldsw + _i * 8192), 16, 0, 0); } while (0)
#define PG8_LDA(dst, b, h) do { _Pragma("unroll") for (int m = 0; m < 4; ++m) _Pragma("unroll") for (int k = 0; k < 2; ++k) dst[m][k] = *(const PG8_LAS bf16x8*)(lds + PG8_SA(b, h) + aoff + m * 2048 + k * 1024); } while (0)
#define PG8_LDB(dst, b, h) do { _Pragma("unroll") for (int n = 0; n < 2; ++n) _Pragma("unroll") for (int k = 0; k < 2; ++k) dst[n][k] = *(const PG8_LAS bf16x8*)(lds + PG8_SB(b, h) + boff + n * 2048 + k * 1024); } while (0)
#define PG8_MMA(ai, bj, At, Bt) do { __builtin_amdgcn_s_setprio(1); _Pragma("unroll") for (int m = 0; m < 4; ++m) _Pragma("unroll") for (int n = 0; n < 2; ++n) _Pragma("unroll") for (int k = 0; k < 2; ++k) \
        acc[ai][bj][m][n] = __builtin_amdgcn_mfma_f32_16x16x32_bf16(Bt[n][k], At[m][k], acc[ai][bj][m][n], 0, 0, 0); __builtin_amdgcn_s_setprio(0); } while (0)
#define PG8_WAIT_V(n) asm volatile("s_waitcnt vmcnt(" #n ")" ::: "memory")
#define PG8_WAIT_L(n) asm volatile("s_waitcnt lgkmcnt(" #n ")" ::: "memory")
#define PG8_BAR __builtin_amdgcn_s_barrier()
#define PG8_SCHED __builtin_amdgcn_sched_barrier(0)
    Unit cur, nxt; int ui = 0;
    if (!S.next(0, cur)) return;
    f32x4 acc[2][2][4][2];
#pragma unroll
    for (int a = 0; a < 2; ++a)
#pragma unroll
        for (int b = 0; b < 2; ++b)
#pragma unroll
            for (int m = 0; m < 4; ++m)
#pragma unroll
                for (int n = 0; n < 2; ++n) acc[a][b][m][n] = (f32x4){0.f, 0.f, 0.f, 0.f};
    bf16x8 At[4][2], B0[2][2], B1[2][2];
    const char* cA = (const char*)g.A + (size_t)cur.pm * tstep; const char* cB = (const char*)g.Bt + (size_t)cur.pn * tstep;
    S.a_ready(cur);
    if constexpr (SP2) {
        PG8_STAGE(PG8_SB(0, 0), cB, voffB); PG8_STAGE(PG8_SB(0, 1), cB + hstep, voffB); PG8_STAGE(PG8_SA(0, 0), cA, voffA); PG8_STAGE(PG8_SA(0, 1), cA + hstep, voffA);
        if (wr == 1) PG8_BAR;
        PG8_WAIT_V(2); PG8_BAR;
        PG8_STAGE(PG8_SB(1, 0), cB + kstep, voffB); PG8_STAGE(PG8_SA(1, 0), cA + kstep, voffA); PG8_STAGE(PG8_SB(1, 1), cB + hstep + kstep, voffB);
        PG8_WAIT_V(6); PG8_BAR;
    } else {
        PG8_STAGE(PG8_SB(0, 0), cB, voffB); PG8_STAGE(PG8_SA(0, 0), cA, voffA); PG8_STAGE(PG8_SB(0, 1), cB + hstep, voffB); PG8_STAGE(PG8_SA(0, 1), cA + hstep, voffA);
        if (wr == 1) PG8_BAR;
        PG8_WAIT_V(4); PG8_BAR;
        PG8_STAGE(PG8_SB(1, 0), cB + kstep, voffB); PG8_STAGE(PG8_SA(1, 0), cA + kstep, voffA); PG8_STAGE(PG8_SB(1, 1), cB + hstep + kstep, voffB);
        PG8_WAIT_V(6); PG8_BAR;
    }
    for (;;) {
        const bool has_next = S.next(ui + 1, nxt);
        const char* nA = has_next ? (const char*)g.A + (size_t)nxt.pm * tstep : cA; const char* nB = has_next ? (const char*)g.Bt + (size_t)nxt.pn * tstep : cB;
        for (int t = 0; t < nt; t += 2) {
            const bool last = (t == nt - 2);
            const char* a1 = cA + (size_t)(t + 1) * kstep;
            const char* a2 = last ? nA : cA + (size_t)(t + 2) * kstep; const char* b2 = last ? nB : cB + (size_t)(t + 2) * kstep;
            const char* a3 = a2 + kstep; const char* b3 = b2 + kstep;
            if (last && has_next) S.a_ready(nxt);
            if constexpr (SP2) {
            PG8_LDB(B0, 0, 0); PG8_LDB(B1, 0, 1); PG8_SCHED; PG8_LDA(At, 0, 0); PG8_STAGE(PG8_SA(1, 1), a1 + hstep, voffA);
            PG8_WAIT_V(8); PG8_WAIT_L(0); PG8_BAR; PG8_MMA(0, 0, At, B0); PG8_MMA(0, 1, At, B1); PG8_BAR; PG8_SCHED;
            PG8_LDA(At, 0, 1); PG8_STAGE(PG8_SB(0, 0), b2, voffB); PG8_STAGE(PG8_SB(0, 1), b2 + hstep, voffB); PG8_STAGE(PG8_SA(0, 0), a2, voffA);
            PG8_WAIT_V(8); PG8_WAIT_L(0); PG8_BAR; PG8_MMA(1, 0, At, B0); PG8_MMA(1, 1, At, B1); PG8_BAR; PG8_SCHED;
            PG8_LDB(B0, 1, 0); PG8_LDB(B1, 1, 1); PG8_SCHED; PG8_LDA(At, 1, 0); PG8_STAGE(PG8_SA(0, 1), a2 + hstep, voffA);
            PG8_WAIT_V(8); PG8_WAIT_L(0); PG8_BAR; PG8_MMA(0, 0, At, B0); PG8_MMA(0, 1, At, B1); PG8_BAR; PG8_SCHED;
            PG8_LDA(At, 1, 1); PG8_STAGE(PG8_SB(1, 0), b3, voffB); PG8_STAGE(PG8_SB(1, 1), b3 + hstep, voffB); PG8_STAGE(PG8_SA(1, 0), a3, voffA);
            PG8_WAIT_V(8); PG8_WAIT_L(0); PG8_BAR; PG8_MMA(1, 0, At, B0); PG8_MMA(1, 1, At, B1); PG8_BAR; PG8_SCHED;
            } else {
            PG8_LDB(B0, 0, 0); PG8_SCHED; PG8_LDA(At, 0, 0); PG8_STAGE(PG8_SA(1, 1), a1 + hstep, voffA);
            PG8_WAIT_L(8); PG8_BAR; PG8_WAIT_L(0); PG8_MMA(0, 0, At, B0); PG8_BAR; PG8_SCHED;
            PG8_LDB(B1, 0, 1); PG8_STAGE(PG8_SB(0, 0), b2, voffB);
            PG8_BAR; PG8_WAIT_L(0); PG8_MMA(0, 1, At, B1); PG8_BAR;
            PG8_LDA(At, 0, 1); PG8_STAGE(PG8_SA(0, 0), a2, voffA);
            PG8_BAR; PG8_WAIT_L(0); PG8_MMA(1, 0, At, B0); PG8_BAR; PG8_SCHED;
            PG8_STAGE(PG8_SB(0, 1), b2 + hstep, voffB);
            PG8_WAIT_V(6); PG8_BAR; PG8_MMA(1, 1, At, B1); PG8_BAR;
            PG8_LDB(B0, 1, 0); PG8_SCHED; PG8_LDA(At, 1, 0); PG8_STAGE(PG8_SA(0, 1), a2 + hstep, voffA);
            PG8_WAIT_L(8); PG8_BAR; PG8_WAIT_L(0); PG8_MMA(0, 0, At, B0); PG8_BAR; PG8_SCHED;
            PG8_LDB(B1, 1, 1); PG8_STAGE(PG8_SB(1, 0), b3, voffB);
            PG8_BAR; PG8_WAIT_L(0); PG8_MMA(0, 1, At, B1); PG8_BAR;
            PG8_LDA(At, 1, 1); PG8_STAGE(PG8_SA(1, 0), a3, voffA);
            PG8_BAR; PG8_WAIT_L(0); PG8_MMA(1, 0, At, B0); PG8_BAR; PG8_SCHED;
            PG8_STAGE(PG8_SB(1, 1), b3 + hstep, voffB);
            PG8_WAIT_V(6); PG8_BAR; PG8_MMA(1, 1, At, B1); PG8_BAR;
            }
        }
        if constexpr (ALIGN_EPI) { if (wr == 0) PG8_BAR; }
        if constexpr (!Epi::AFTER_DRAIN) { E(acc, cur, wr, wc, fr, fq); S.done(cur); }
        if (!has_next) break;
#pragma unroll
        for (int a = 0; a < 2; ++a)
#pragma unroll
            for (int b = 0; b < 2; ++b)
#pragma unroll
                for (int m = 0; m < 4; ++m)
#pragma unroll
                    for (int n = 0; n < 2; ++n) acc[a][b][m][n] = (f32x4){0.f, 0.f, 0.f, 0.f};
        cur = nxt; cA = nA; cB = nB; ++ui;
        if constexpr (ALIGN_EPI) { if (wr == 1) PG8_BAR; }
    }
    PG8_WAIT_V(0);
    if constexpr (!ALIGN_EPI) { if (wr == 0) PG8_BAR; }
    PG8_BAR;
    if constexpr (Epi::AFTER_DRAIN) { E.fused(acc, cur, wr, wc, fr, fq, lds, wid, lane); S.done(cur); }
#undef PG8_SA
#undef PG8_SB
#undef PG8_STAGE
#undef PG8_LDA
#undef PG8_LDB
#undef PG8_MMA
#undef PG8_WAIT_V
#undef PG8_WAIT_L
#undef PG8_BAR
#undef PG8_SCHED
}
}
namespace attn_body {
using bf16=__hip_bfloat16;
using bf16x8=__attribute__((ext_vector_type(8)))short;
using s16x4=__attribute__((ext_vector_type(4)))short;
using f32x16=__attribute__((ext_vector_type(16)))float;
using u32x4=__attribute__((ext_vector_type(4)))unsigned;
constexpr int BATCH=8,NHEAD=16,SEQ=2048,D=64,DM=NHEAD*D;
constexpr int NW=8,QBLK=32,QB=QBLK*NW,KVBLK=64,NQB=SEQ/QB;
constexpr int ATTN_PITCH=DM, ATTN_UNIT_ROWS=QB;
__device__ __forceinline__ int crow(int r,int hi){return (r&3)+8*(r>>2)+4*hi;}
#define SBAR() __builtin_amdgcn_sched_barrier(0)
__device__ __forceinline__ void cmask(f32x16&p0,f32x16&p1,int jb,int qrel,int hi){
  const float NEG=-INFINITY; int kb=64*jb+4*hi;
  #pragma unroll
  for(int r=0;r<16;++r){int kv=kb+(r&3)+8*(r>>2); if(kv>qrel)p0[r]=NEG; if(kv+32>qrel)p1[r]=NEG;}
}

constexpr int NSLOT=3, SLOTB=8192;
constexpr int LDS_K=0, LDS_V=NSLOT*SLOTB, LDS_WS=2*NSLOT*SLOTB, LDS_OST=LDS_WS+NW*64*4, LDS_CB=LDS_OST+NW*4096, LDS_BYTES=LDS_CB+SEQ*16;
constexpr float C2=0.125f*1.4426950408889634f;
__device__ __forceinline__ void glds16(const void*gsrc,unsigned lds_dst){unsigned keep;
  asm volatile("s_mov_b32 %0, m0\n\ts_mov_b32 m0, %2\n\ts_nop 0\n\tglobal_load_lds_dwordx4 %1, off\n\ts_mov_b32 m0, %0":"=&s"(keep):"v"(gsrc),"s"(lds_dst):"memory");}
__device__ __forceinline__ float max3f(float a,float b,float c){float r;asm("v_max3_f32 %0, %1, %2, %3":"=v"(r):"v"(a),"v"(b),"v"(c));return r;}
__device__ __forceinline__ float max2f(float a,float b){float r;asm("v_max_f32_e32 %0, %1, %2":"=v"(r):"v"(a),"v"(b));return r;}
__device__ __forceinline__ float fadd_s(float a,float b){float r;asm("v_add_f32_e32 %0, %1, %2":"=v"(r):"v"(a),"v"(b));return r;}
__device__ __forceinline__ float fsub_s(float a,float b){float r;asm("v_sub_f32_e32 %0, %1, %2":"=v"(r):"v"(a),"v"(b));return r;}
typedef float f32x2_t __attribute__((ext_vector_type(2))); typedef __bf16 bf16x2_t __attribute__((ext_vector_type(2)));
__device__ __forceinline__ unsigned cvtpk_s(float lo,float hi){f32x2_t v={lo,hi};bf16x2_t b=__builtin_convertvector(v,bf16x2_t);return __builtin_bit_cast(unsigned,b);}
#define WAIT_BAR(N) asm volatile("s_waitcnt vmcnt(" #N ") lgkmcnt(0)\n\ts_barrier":::"memory")

__device__ __forceinline__ void qkt(f32x16&p0,f32x16&p1,const char*Kslot,const bf16x8*qr,const f32x16&negm,int r32,int hi){
  const char*kb=Kslot+hi*1024+r32*16;
  #pragma unroll
  for(int d0=0;d0<4;++d0){
    const bf16x8 b0=*reinterpret_cast<const bf16x8*>(kb+d0*2048);
    const bf16x8 b1=*reinterpret_cast<const bf16x8*>(kb+d0*2048+512);
    if(d0==0){const f32x16 z_=f32x16{};p0=__builtin_amdgcn_mfma_f32_32x32x16_bf16(b0,qr[0],z_,0,0,0);p1=__builtin_amdgcn_mfma_f32_32x32x16_bf16(b1,qr[0],z_,0,0,0);}
    else{p0=__builtin_amdgcn_mfma_f32_32x32x16_bf16(b0,qr[d0],p0,0,0,0);p1=__builtin_amdgcn_mfma_f32_32x32x16_bf16(b1,qr[d0],p1,0,0,0);}}
}
typedef __attribute__((address_space(3))) const char* lds_cptr;
typedef short v4i16_t __attribute__((ext_vector_type(4)));
__device__ __forceinline__ void kload8(bf16x8*kf,lds_cptr kp){
  kf[0]=*(const __attribute__((address_space(3))) bf16x8*)(kp);      kf[1]=*(const __attribute__((address_space(3))) bf16x8*)(kp+512);
  kf[2]=*(const __attribute__((address_space(3))) bf16x8*)(kp+2048); kf[3]=*(const __attribute__((address_space(3))) bf16x8*)(kp+2560);
  kf[4]=*(const __attribute__((address_space(3))) bf16x8*)(kp+4096); kf[5]=*(const __attribute__((address_space(3))) bf16x8*)(kp+4608);
  kf[6]=*(const __attribute__((address_space(3))) bf16x8*)(kp+6144); kf[7]=*(const __attribute__((address_space(3))) bf16x8*)(kp+6656);
}
__device__ __forceinline__ void kload2(bf16x8*kf,lds_cptr kp,int j){ kf[2*j]=*(const __attribute__((address_space(3))) bf16x8*)(kp+j*2048); kf[2*j+1]=*(const __attribute__((address_space(3))) bf16x8*)(kp+j*2048+512); }
__device__ __forceinline__ s16x4 vtr(lds_cptr p){ return __builtin_bit_cast(s16x4,__builtin_amdgcn_ds_read_tr16_b64_v4i16((__attribute__((address_space(3))) v4i16_t*)p)); }
__device__ __forceinline__ float rowmax(const f32x16&p0,const f32x16&p1){
  float a=max3f(p0[0],p0[1],p1[0]),b=max3f(p0[2],p0[3],p1[1]);a=max3f(a,p1[2],p1[3]);
  #pragma unroll
  for(int r=4;r<16;r+=4){a=max3f(a,p0[r],p0[r+1]);b=max3f(b,p0[r+2],p0[r+3]);a=max3f(a,p1[r],p1[r+1]);b=max3f(b,p1[r+2],p1[r+3]);}
  const float m=max2f(a,b);
  auto rr=__builtin_amdgcn_permlane32_swap(__float_as_uint(m),__float_as_uint(m),false,false);
  return max2f(__uint_as_float(rr[0]),__uint_as_float(rr[1]));
}
__device__ __forceinline__ void pv(f32x16*o,int vb,bf16x8 pa0,bf16x8 pa1,bf16x8 pa2,bf16x8 pa3){
  #pragma unroll
  for(int d0=0;d0<2;++d0){s16x4 lo[4],hi[4];
    #pragma unroll
    for(int ks=0;ks<4;++ks){
      asm volatile("ds_read_b64_tr_b16 %0,%1 offset:%c2":"=&v"(lo[ks]):"v"(vb),"i"(d0*4096+ks*1024):"memory");
      asm volatile("ds_read_b64_tr_b16 %0,%1 offset:%c2":"=&v"(hi[ks]):"v"(vb),"i"(d0*4096+ks*1024+512):"memory");}
    asm volatile("s_waitcnt lgkmcnt(0)":::"memory");SBAR();
    #define PK(k) (bf16x8){lo[k][0],lo[k][1],lo[k][2],lo[k][3],hi[k][0],hi[k][1],hi[k][2],hi[k][3]}
    o[d0]=__builtin_amdgcn_mfma_f32_32x32x16_bf16(pa0,PK(0),o[d0],0,0,0);
    o[d0]=__builtin_amdgcn_mfma_f32_32x32x16_bf16(pa1,PK(1),o[d0],0,0,0);
    o[d0]=__builtin_amdgcn_mfma_f32_32x32x16_bf16(pa2,PK(2),o[d0],0,0,0);
    o[d0]=__builtin_amdgcn_mfma_f32_32x32x16_bf16(pa3,PK(3),o[d0],0,0,0);
    #undef PK
  }
}

#ifndef ATTN_STORE16
#define ATTN_STORE16(p,v) (*(u32x4*)(p)=(v))
#endif
template<int THRL> __device__ __forceinline__ void attn_unit(int b,int h,int qb,const bf16*Q,const bf16*__restrict__ K,const bf16*__restrict__ V,bf16*O,char*shm){
  int tid_o=threadIdx.x; asm volatile("":"+v"(tid_o));
  const int tid=tid_o,lane=tid&63,r32=lane&31,hi=lane>>5; const int wid=__builtin_amdgcn_readfirstlane(tid>>6);
  const long rowbase=(long)b*SEQ; const int q0=qb*QB;
  const bf16*Qw=Q+(rowbase+q0+wid*QBLK)*DM+h*D;
  const bf16*Kh=K+rowbase*DM+h*D,*Vh=V+rowbase*DM+h*D;
  const unsigned lds0=(unsigned)(uintptr_t)shm;
  float*wsf=(float*)(shm+LDS_WS)+wid*64;
  const bf16*ksrc=Kh+(long)lane*DM+wid*8;
  const bf16*vsrc=Vh+(long)(16*(wid&3)+(lane>>2))*DM+(wid>>2)*32+(lane&3)*8;
  const unsigned kdst=lds0+LDS_K+wid*1024, vdst=lds0+LDS_V+wid*1024;
  #define DMA_K(t,slot) glds16(ksrc+(long)(t)*KVBLK*DM,(unsigned)__builtin_amdgcn_readfirstlane(kdst+(slot)))
  #define DMA_V(t,slot) glds16(vsrc+(long)(t)*KVBLK*DM,(unsigned)__builtin_amdgcn_readfirstlane(vdst+(slot)))
  const int vb0=(int)(lds0+LDS_V)+((lane>>4)&1)*32+(lane&3)*8+(4*hi+((lane&15)>>2))*64;
  const char*Kbase=shm+LDS_K; bf16x8 kf[8];
  #define BIASMMA(P0,P1,t) do{ const bf16x8 kb0_=*(const __attribute__((address_space(3))) bf16x8*)(cbp+(t)*1024), kb1_=*(const __attribute__((address_space(3))) bf16x8*)(cbp+(t)*1024+512); \
    P0=__builtin_amdgcn_mfma_f32_32x32x16_bf16(kb0_,__builtin_bit_cast(bf16x8,qaug),P0,0,0,0); P1=__builtin_amdgcn_mfma_f32_32x32x16_bf16(kb1_,__builtin_bit_cast(bf16x8,qaug),P1,0,0,0); }while(0)
  #define QROUND(x) __uint_as_float(cvtpk_s((x),0.f)<<16)
  #define UPD_QAUG() do{ qaug.y=hi?0u:(0x3f80u|(__float_as_uint(-mhat)&0xffff0000u)); }while(0)
  const lds_cptr shm3=(lds_cptr)shm; const lds_cptr kp0=shm3+LDS_K+hi*1024+r32*16; const lds_cptr vp0=shm3+LDS_V+((lane>>4)&1)*32+(lane&3)*8+(4*hi+((lane&15)>>2))*64;
  const lds_cptr cbp=shm3+LDS_CB+r32*16;
  u32x4 qaug=(u32x4){hi?0u:0x3f803f80u,hi?0u:0x00003f80u,0u,0u};
  typedef unsigned u32x2_t __attribute__((ext_vector_type(2)));
  const int NT=(q0+QB)/KVBLK;
  DMA_K(0,0);DMA_V(0,0);DMA_K(1,SLOTB);
  bf16x8 qr[4];
  #pragma unroll
  for(int d0=0;d0<4;++d0)qr[d0]=*reinterpret_cast<const bf16x8*>(&Qw[(long)r32*DM+d0*16+hi*8]);
  float mhat=0.f,l_reg=0.f;f32x16 o[2];{float zz_=0.f;asm volatile("":"+v"(zz_));_Pragma("unroll") for(int r=0;r<16;++r){o[0][r]=zz_;o[1][r]=zz_;}}    const f32x16 negm=f32x16{};
  const int qrel=wid*QBLK+r32;
  #define CMASK(P0,P1,t) do{int jb_=(t)-(NT-4); if(jb_>=0)cmask(P0,P1,jb_,qrel,hi);}while(0)
  bool resc=false;
  #define START(P0,P1) do{ const float rm=rowmax(P0,P1); resc=false; \
    { const float tq_=QROUND(mhat+rm); const float dl=tq_-mhat; mhat=tq_; \
      _Pragma("unroll") for(int r=0;r<16;++r){P0[r]=fsub_s(P0[r],dl);P1[r]=fsub_s(P1[r],dl);} \
      UPD_QAUG(); } \
    _Pragma("unroll") for(int r=0;r<16;++r)P0[r]=__builtin_amdgcn_exp2f(P0[r]); }while(0)
  #define RESC() do{ if(resc){ asm volatile("s_waitcnt lgkmcnt(0)":::"memory"); \
      _Pragma("unroll") for(int d_=0;d_<2;++d_) _Pragma("unroll") for(int r=0;r<16;++r)o[d_][r]*=wsf[crow(r,hi)]; } }while(0)
  f32x16 pA0,pA1,pB0,pB1;
  int sl_prev=0,sl_cur=0,sl_next=SLOTB;
  #define ROT() do{sl_prev=sl_cur;sl_cur=sl_next;sl_next=(sl_next==(NSLOT-1)*SLOTB)?0:sl_next+SLOTB;}while(0)
  DMA_K(2,2*SLOTB);
  WAIT_BAR(3);
  qkt(pA0,pA1,Kbase,qr,negm,r32,hi);BIASMMA(pA0,pA1,0);asm volatile("s_nop 15\n\ts_nop 7":"+v"(pA0),"+v"(pA1));CMASK(pA0,pA1,0);
  START(pA0,pA1);
  _Pragma("unroll") for(int r=0;r<16;++r)pA1[r]=__builtin_amdgcn_exp2f(pA1[r]);
  WAIT_BAR(0);
  DMA_K(3,0);DMA_V(1,SLOTB);
  ROT();
  kload8(kf,kp0+sl_cur);
  WAIT_BAR(2);
  s16x4 vlo[8],vhi[8]; u32x4 pw0,pw1,pw2,pw3;
  #define PKW(P,B) cvtpk_s(P[B],P[B+1])
  #define PAF(k) __builtin_bit_cast(bf16x8,pw##k)
  #define VFR(i) (bf16x8){vlo[i][0],vlo[i][1],vlo[i][2],vlo[i][3],vhi[i][0],vhi[i][1],vhi[i][2],vhi[i][3]}
  #define PIN(x) asm volatile("":"+v"(x))
  #define MX3(a,b,c) __builtin_fmaxf(__builtin_fmaxf((a),(b)),(c))
  #define GAPA(MF,A0,A1,A2,A3,W0,W1,PW) do{ MF; sacc+=A0; sacc+=A1; sacc+=A2; sacc+=A3; PIN(sacc); W0; W1; PIN(PW); SBAR(); }while(0)
  #define EX(v) __builtin_amdgcn_exp2f(v)
  #define GAPB(MF,X,B) do{ MF; X[B]=EX(X[B]); X[B+1]=EX(X[B+1]); X[B+2]=EX(X[B+2]); X[B+3]=EX(X[B+3]); PIN(X); SBAR(); }while(0)
  #define VRD(i) do{ vlo[i]=vtr(vp_+(((i)>>2)*4096+((i)&3)*1024)); vhi[i]=vtr(vp_+(((i)>>2)*4096+((i)&3)*1024+512)); }while(0)
  #define KRD(G,j) do{ if(G){ kload2(kf,kp0+sl_next,j); SBAR(); } }while(0)
  #define STEP(C0,C1,P0,P1,t,GK,GV,GL) do{ SBAR(); \
    const lds_cptr vp_=vp0+sl_prev; \
    const bf16x8 kbA_=*(const __attribute__((address_space(3))) bf16x8*)(cbp+(t)*1024), kbB_=*(const __attribute__((address_space(3))) bf16x8*)(cbp+(t)*1024+512);     \
    VRD(0); SBAR(); float sacc=(P0[0]+P0[1]); \
    GAPA(C0=__builtin_amdgcn_mfma_f32_32x32x16_bf16(kf[0],qr[0],negm,0,0,0), P0[2],P0[3],P0[4],P0[5],     pw0[0]=PKW(P0,0), pw0[1]=PKW(P0,2), pw0); \
    VRD(4); SBAR(); GAPA(C1=__builtin_amdgcn_mfma_f32_32x32x16_bf16(kf[1],qr[0],negm,0,0,0), P0[6],P0[7],P0[8],P0[9],     pw0[2]=PKW(P0,4), pw0[3]=PKW(P0,6), pw0); \
    C0=__builtin_amdgcn_mfma_f32_32x32x16_bf16(kbA_,__builtin_bit_cast(bf16x8,qaug),C0,0,0,0); C1=__builtin_amdgcn_mfma_f32_32x32x16_bf16(kbB_,__builtin_bit_cast(bf16x8,qaug),C1,0,0,0); SBAR(); \
    VRD(1); SBAR(); GAPA(C0=__builtin_amdgcn_mfma_f32_32x32x16_bf16(kf[2],qr[1],C0,0,0,0),   P0[10],P0[11],P0[12],P0[13], pw1[0]=PKW(P0,8), pw1[1]=PKW(P0,10), pw1); \
    VRD(5); SBAR(); GAPA(C1=__builtin_amdgcn_mfma_f32_32x32x16_bf16(kf[3],qr[1],C1,0,0,0),   P0[14],P0[15],P1[0],P1[1],   pw1[2]=PKW(P0,12),pw1[3]=PKW(P0,14), pw1); \
    VRD(2); SBAR(); GAPA(C0=__builtin_amdgcn_mfma_f32_32x32x16_bf16(kf[4],qr[2],C0,0,0,0),   P1[2],P1[3],P1[4],P1[5],     pw2[0]=PKW(P1,0), pw2[1]=PKW(P1,2), pw2); \
    VRD(6); SBAR(); GAPA(C1=__builtin_amdgcn_mfma_f32_32x32x16_bf16(kf[5],qr[2],C1,0,0,0),   P1[6],P1[7],P1[8],P1[9],     pw2[2]=PKW(P1,4), pw2[3]=PKW(P1,6), pw2); \
    VRD(3); SBAR(); GAPA(C0=__builtin_amdgcn_mfma_f32_32x32x16_bf16(kf[6],qr[3],C0,0,0,0),   P1[10],P1[11],P1[12],P1[13], pw3[0]=PKW(P1,8), pw3[1]=PKW(P1,10), pw3); \
    VRD(7); SBAR(); GAPA(C1=__builtin_amdgcn_mfma_f32_32x32x16_bf16(kf[7],qr[3],C1,0,0,0),   P1[14],P1[15],0.f,0.f,       pw3[2]=PKW(P1,12),pw3[3]=PKW(P1,14), pw3); \
    l_reg+=sacc; \
    if(GK){DMA_K((t)+3,sl_cur);} if(GV){DMA_V((t)+1,sl_next);} \
    CMASK(C0,C1,t); \
    { float a=MX3(C0[0],C0[1],C1[0]),b=MX3(C0[2],C0[3],C1[1]); a=MX3(a,C1[2],C1[3]); \
      _Pragma("unroll") for(int r=4;r<16;r+=4){a=MX3(a,C0[r],C0[r+1]);b=MX3(b,C0[r+2],C0[r+3]);a=MX3(a,C1[r],C1[r+1]);b=MX3(b,C1[r+2],C1[r+3]);} \
      float rm=__builtin_fmaxf(a,b); { auto rr=__builtin_amdgcn_permlane32_swap(__float_as_uint(rm),__float_as_uint(rm),false,false); rm=__builtin_fmaxf(__uint_as_float(rr[0]),__uint_as_float(rr[1])); } \
      resc=false; \
      if(__builtin_expect(__any(rm>(float)THRL),0)){ const float tq_=QROUND(mhat+__builtin_fmaxf(rm,0.f)); const float dl=tq_-mhat; mhat=tq_; \
        _Pragma("unroll") for(int r=0;r<16;++r){C0[r]-=dl;C1[r]-=dl;} \
        UPD_QAUG(); \
        const float f=__builtin_amdgcn_exp2f(-dl); l_reg*=f; if(hi==0)wsf[r32]=f; resc=true; } } \
    SBAR(); \
    GAPB(o[0]=__builtin_amdgcn_mfma_f32_32x32x16_bf16(PAF(0),VFR(0),o[0],0,0,0), C0,0); \
    GAPB(o[1]=__builtin_amdgcn_mfma_f32_32x32x16_bf16(PAF(0),VFR(4),o[1],0,0,0), C0,4); \
    KRD(GL,0); GAPB(o[0]=__builtin_amdgcn_mfma_f32_32x32x16_bf16(PAF(1),VFR(1),o[0],0,0,0), C0,8); \
    KRD(GL,1); GAPB(o[1]=__builtin_amdgcn_mfma_f32_32x32x16_bf16(PAF(1),VFR(5),o[1],0,0,0), C0,12); \
    KRD(GL,2); GAPB(o[0]=__builtin_amdgcn_mfma_f32_32x32x16_bf16(PAF(2),VFR(2),o[0],0,0,0), C1,0); \
    KRD(GL,3); GAPB(o[1]=__builtin_amdgcn_mfma_f32_32x32x16_bf16(PAF(2),VFR(6),o[1],0,0,0), C1,4); \
    GAPB(o[0]=__builtin_amdgcn_mfma_f32_32x32x16_bf16(PAF(3),VFR(3),o[0],0,0,0), C1,8); \
    GAPB(o[1]=__builtin_amdgcn_mfma_f32_32x32x16_bf16(PAF(3),VFR(7),o[1],0,0,0), C1,12); \
    }while(0)
  int t=1;
  #undef CMASK
  #define CMASK(P0,P1,t) do{}while(0)
  for(;t+5<NT;t+=2){
    STEP(pB0,pB1,pA0,pA1,t,true,true,true);     WAIT_BAR(2); RESC(); ROT();
    STEP(pA0,pA1,pB0,pB1,t+1,true,true,true);   WAIT_BAR(2); RESC(); ROT();
  }
  #undef CMASK
  #define CMASK(P0,P1,t) do{int jb_=(t)-(NT-4); if(jb_>=0)cmask(P0,P1,jb_,qrel,hi);}while(0)
  #define ENDW(tt) do{ if((tt)+3<NT){WAIT_BAR(2);} else if((tt)+2<NT){WAIT_BAR(1);} else {WAIT_BAR(0);} }while(0)
  for(;t+1<NT;t+=2){
    STEP(pB0,pB1,pA0,pA1,t,(t+3<NT),(t+1<NT),(t+1<NT));       ENDW(t);   RESC(); ROT();
    STEP(pA0,pA1,pB0,pB1,t+1,(t+4<NT),(t+2<NT),(t+2<NT));     ENDW(t+1); RESC(); ROT();
  }
  STEP(pB0,pB1,pA0,pA1,NT-1,false,false,false); RESC();
  { float sacc=pB0[0]+pB0[1]; _Pragma("unroll") for(int r=2;r<16;++r)sacc+=pB0[r]; _Pragma("unroll") for(int r=0;r<16;++r)sacc+=pB1[r]; l_reg+=sacc;
    pw0=(u32x4){PKW(pB0,0),PKW(pB0,2),PKW(pB0,4),PKW(pB0,6)};pw1=(u32x4){PKW(pB0,8),PKW(pB0,10),PKW(pB0,12),PKW(pB0,14)};pw2=(u32x4){PKW(pB1,0),PKW(pB1,2),PKW(pB1,4),PKW(pB1,6)};pw3=(u32x4){PKW(pB1,8),PKW(pB1,10),PKW(pB1,12),PKW(pB1,14)};
    SBAR(); pv(o,vb0+sl_cur,PAF(0),PAF(1),PAF(2),PAF(3)); }
  #undef PKW
  #undef PAF
  #undef VFR
  #undef PIN
  #undef MX3
  #undef GAPA
  #undef GAPB
  #undef EX
  #undef VRD
  #undef KRD
  #undef STEP
  #undef ENDW
  {auto rr=__builtin_amdgcn_permlane32_swap(__float_as_uint(l_reg),__float_as_uint(l_reg),false,false);l_reg=__uint_as_float(rr[0])+__uint_as_float(rr[1]);}
  if(hi==0)wsf[32+r32]=l_reg;asm volatile("s_waitcnt lgkmcnt(0)":::"memory");
  float rli[16];
  #pragma unroll
  for(int r=0;r<16;++r)rli[r]=__builtin_amdgcn_rcpf(wsf[32+crow(r,hi)]);
  bf16*Ow=O+(rowbase+q0+wid*QBLK)*DM+h*D;
  { bf16*stg=(bf16*)(shm+LDS_OST)+wid*2048;
    #pragma unroll
    for(int r=0;r<16;++r){const int orow=crow(r,hi);
      #pragma unroll
      for(int d0=0;d0<2;++d0)stg[orow*64+d0*32+r32]=__float2bfloat16(o[d0][r]*rli[r]);}
    asm volatile("s_waitcnt lgkmcnt(0)":::"memory");
    #pragma unroll
    for(int i=0;i<4;++i){const int row=i*8+(lane>>3),ch=lane&7; const u32x4 v=*(const u32x4*)(stg+row*64+ch*8); ATTN_STORE16(Ow+(long)row*DM+ch*8,v);} }
  asm volatile("s_waitcnt lgkmcnt(0)\n\ts_barrier":::"memory");
  #undef DMA_K
  #undef DMA_V
  #undef CMASK
  #undef START
  #undef RESC
  #undef ROT
  #undef BIASMMA
  #undef UPD_QAUG
  #undef QROUND
}
constexpr int ATTN_LDS_BYTES=LDS_BYTES;
#undef SBAR
#undef WAIT_BAR
}
namespace mls {
#define MLAS __attribute__((address_space(3)))
typedef unsigned short bf16_t;
typedef short bf16x8 __attribute__((ext_vector_type(8)));
typedef float f32x4 __attribute__((ext_vector_type(4)));
typedef unsigned u32x4 __attribute__((ext_vector_type(4)));
typedef unsigned u32x2 __attribute__((ext_vector_type(2)));
constexpr int T = 2048, DM = 1024, QS = 264, TS = 72;
constexpr int L_Q = 0, L_K = L_Q + 64 * QS * 2, L_KWT = L_K + 64 * QS * 2, L_VT = L_KWT + 256 * TS * 2, L_SP = L_VT + 64 * TS * 2, L_XCH = L_SP + 64 * TS * 2, L_SM = L_XCH + 8 * 2 * 64 * 16;
constexpr int F_A2 = 0, F_R2 = 64, F_WI = 128, F_FL = 192, F_DENP = 256, F_NQ = 384, F_NVEC = 448, F_STATP = 704, F_END = F_STATP + 4 * 64 * 2;
constexpr int LDS_BYTES = L_SM + F_END * 4;
static_assert(LDS_BYTES <= 147456 - 1024, "mLSTM LDS");
__device__ __forceinline__ unsigned cvtpk(float lo, float hi) { unsigned r; asm volatile("v_cvt_pk_bf16_f32 %0, %1, %2" : "=v"(r) : "v"(lo), "v"(hi)); return r; }
__device__ __forceinline__ float blo(unsigned w) { return __uint_as_float(w << 16); }
__device__ __forceinline__ float bhi(unsigned w) { return __uint_as_float(w & 0xffff0000u); }
#define MLS_LBAR() do { asm volatile("s_waitcnt lgkmcnt(0)" ::: "memory"); __builtin_amdgcn_s_barrier(); asm volatile("" ::: "memory"); } while (0)
#define MMA16(a, b, c) __builtin_amdgcn_mfma_f32_16x16x32_bf16((a), (b), (c), 0, 0, 0)

__device__ __forceinline__ void mlstm_unit(int b, int h, int vs, const bf16_t* Q, const bf16_t* K, bf16_t* VH, const float* mtab, float* stats, MLAS unsigned char* lds, const int pm  ) {
    int tid_o = threadIdx.x; asm volatile("" : "+v"(tid_o));
    const int tid0 = tid_o, w = __builtin_amdgcn_readfirstlane(tid0 >> 6);
    MLAS float* sm = (MLAS float*)(lds + L_SM);
    const size_t row0 = (size_t)b * T;
    const float* mt = mtab + (size_t)(b * 4 + h) * 5 * T;
    const bf16_t* qsrc = Q + (row0 + 4 * (tid0 >> 5)) * DM + h * 256 + 8 * (tid0 & 31);
    const bf16_t* ksrc = K + (row0 + 4 * (tid0 >> 5)) * DM + h * 256 + 8 * (tid0 & 31);
    const bf16_t* vsrc = VH + (row0 + (tid0 >> 3)) * DM + h * 256 + 64 * vs + 8 * (tid0 & 7);
    const int vb = w & 3, dh = w >> 2;
    f32x4 Cacc[8];
#pragma unroll
    for (int i = 0; i < 8; ++i) Cacc[i] = (f32x4){0.f, 0.f, 0.f, 0.f};
    if (tid0 < 256) sm[F_NVEC + tid0] = 0.f;
    u32x4 qraw[4], kraw[4], vraw; f32x4 wend4; float ga2 = 0.f, gr2 = 0.f, gwi = 0.f, gfl = 0.f;
#define MLS_PREFETCH(c, tid) do { const size_t ro_ = (size_t)(c) * 64 * DM; \
        _Pragma("unroll") for (int j_ = 0; j_ < 4; ++j_) { qraw[j_] = *(const u32x4*)(qsrc + ro_ + (size_t)j_ * DM); kraw[j_] = *(const u32x4*)(ksrc + ro_ + (size_t)j_ * DM); } \
        vraw = *(const u32x4*)(vsrc + ro_); \
        wend4 = *(const f32x4*)(mt + 4 * T + (c) * 64 + 4 * ((tid) >> 5)); \
        if (tid < 64) { ga2 = mt[(c) * 64 + tid]; gr2 = mt[T + (c) * 64 + tid]; gwi = mt[2 * T + (c) * 64 + tid]; gfl = mt[3 * T + (c) * 64 + tid]; } } while (0)
    MLS_PREFETCH(0, tid0);
#pragma unroll 1
    for (int c = 0; c < 32; ++c) {
        int tid_i = tid0; asm volatile("" : "+v"(tid_i));
        const int tid = tid_i, lane = tid & 63, g = lane >> 4, c16 = lane & 15, cg = tid & 31, rg = tid >> 5, vc = tid & 7, vr = tid >> 3;
        if (!(pm & 16)) {
#pragma unroll
        for (int j = 0; j < 4; ++j) { *(MLAS u32x4*)(lds + L_Q + ((4 * rg + j) * QS + 8 * cg) * 2) = qraw[j]; *(MLAS u32x4*)(lds + L_K + ((4 * rg + j) * QS + 8 * cg) * 2) = kraw[j]; }
        {
#pragma unroll
            for (int e2 = 0; e2 < 4; ++e2) {
                u32x2 lo, hi;
                lo.x = cvtpk(blo(kraw[0][e2]) * wend4[0], blo(kraw[1][e2]) * wend4[1]); lo.y = cvtpk(blo(kraw[2][e2]) * wend4[2], blo(kraw[3][e2]) * wend4[3]);
                hi.x = cvtpk(bhi(kraw[0][e2]) * wend4[0], bhi(kraw[1][e2]) * wend4[1]); hi.y = cvtpk(bhi(kraw[2][e2]) * wend4[2], bhi(kraw[3][e2]) * wend4[3]);
                const int so = (((rg >> 1) ^ (cg & 7)) * 8 + 4 * (rg & 1)) * 2;
                *(MLAS u32x2*)(lds + L_KWT + (8 * cg + 2 * e2) * TS * 2 + so) = lo; *(MLAS u32x2*)(lds + L_KWT + (8 * cg + 2 * e2 + 1) * TS * 2 + so) = hi; }
        }
        {
#pragma unroll
            for (int e2 = 0; e2 < 4; ++e2) {
                const int so = (((vr >> 3) ^ (vc & 7)) * 8 + (vr & 7)) * 2;
                *(MLAS unsigned short*)(lds + L_VT + (8 * vc + 2 * e2) * TS * 2 + so) = (unsigned short)(vraw[e2] & 0xffffu);
                *(MLAS unsigned short*)(lds + L_VT + (8 * vc + 2 * e2 + 1) * TS * 2 + so) = (unsigned short)(vraw[e2] >> 16); }
        }
        if (tid < 64) { sm[F_A2 + tid] = ga2; sm[F_R2 + tid] = gr2; sm[F_WI + tid] = gwi; sm[F_FL + tid] = gfl; }
        }
        __syncthreads();
        if (c + 1 < 32 && !(pm & 8192)) MLS_PREFETCH(c + 1, tid);
        if (c > 0 && tid < 64 && !(pm & 4096)) {
            float s1 = 0.f, s2 = 0.f;
#pragma unroll
            for (int k = 0; k < 4; ++k) { s1 += sm[F_STATP + (k * 64 + tid) * 2]; s2 += sm[F_STATP + (k * 64 + tid) * 2 + 1]; }
            float* sp = stats + ((row0 + (size_t)(c - 1) * 64 + tid) * 4 + h) * 2; unsafeAtomicAdd(sp, s1); unsafeAtomicAdd(sp + 1, s2); }
        {
            const int tb = w & 3, sh = w >> 2, t = 16 * tb + c16;
            bf16x8 qf[8];
#pragma unroll
            for (int j = 0; j < 8; ++j) qf[j] = *(const MLAS bf16x8*)(lds + L_Q + (t * QS + 32 * j + 8 * g) * 2);
            const float r2t = sm[F_R2 + t]; float rowsum = 0.f;
#pragma unroll
            for (int blk = 0; blk < 2; ++blk) { const int sb = 2 * sh + blk; u32x2 o; o.x = 0u; o.y = 0u;
                if (sb <= tb && !(pm & 32)) {
                    f32x4 acc = (f32x4){0.f, 0.f, 0.f, 0.f};
#pragma unroll
                    for (int j = 0; j < 8; ++j) { const bf16x8 kf = *(const MLAS bf16x8*)(lds + L_K + ((16 * sb + c16) * QS + 32 * j + 8 * g) * 2); acc = MMA16(kf, qf[j], acc); }
                    const f32x4 a2v = *(const MLAS f32x4*)(sm + F_A2 + 16 * sb + 4 * g); float sp[4];
#pragma unroll
                    for (int i = 0; i < 4; ++i) { const int s = 16 * sb + 4 * g + i; const float wg = __builtin_amdgcn_exp2f(a2v[i] - r2t); sp[i] = (s <= t) ? acc[i] * wg : 0.f; rowsum += sp[i]; }
                    o.x = cvtpk(sp[0], sp[1]); o.y = cvtpk(sp[2], sp[3]); }
                *(MLAS u32x2*)(lds + L_SP + (t * TS + 16 * sb + 4 * g) * 2) = o; }
            rowsum += __shfl_xor(rowsum, 16); rowsum += __shfl_xor(rowsum, 32);
            if (g == 0) sm[F_DENP + sh * 64 + t] = rowsum;
        }
        if (!(pm & 64)) {
            const int t = tid >> 3, part = tid & 7; float s = 0.f;
#pragma unroll
            for (int j = 0; j < 4; ++j) { const u32x4 qv = *(const MLAS u32x4*)(lds + L_Q + (t * QS + 32 * part + 8 * j) * 2);
                const f32x4 n0 = *(const MLAS f32x4*)(sm + F_NVEC + 32 * part + 8 * j), n1 = *(const MLAS f32x4*)(sm + F_NVEC + 32 * part + 8 * j + 4);
                s += blo(qv.x) * n0[0] + bhi(qv.x) * n0[1] + blo(qv.y) * n0[2] + bhi(qv.y) * n0[3] + blo(qv.z) * n1[0] + bhi(qv.z) * n1[1] + blo(qv.w) * n1[2] + bhi(qv.w) * n1[3]; }
            s += __shfl_xor(s, 1); s += __shfl_xor(s, 2); s += __shfl_xor(s, 4);
            if (part == 0) sm[F_NQ + t] = s;
        }
        f32x4 accI[4];
        {
            bf16x8 cf[4];
#pragma unroll
            for (int j = 0; j < 4; ++j) { u32x4 p; p.x = cvtpk(Cacc[2 * j][0], Cacc[2 * j][1]); p.y = cvtpk(Cacc[2 * j][2], Cacc[2 * j][3]); p.z = cvtpk(Cacc[2 * j + 1][0], Cacc[2 * j + 1][1]); p.w = cvtpk(Cacc[2 * j + 1][2], Cacc[2 * j + 1][3]); cf[j] = __builtin_bit_cast(bf16x8, p); }
#pragma unroll
            for (int tb = 0; tb < 4; ++tb) { const int t = 16 * tb + c16; accI[tb] = (f32x4){0.f, 0.f, 0.f, 0.f};
                if (!(pm & 128))
#pragma unroll
                for (int j = 0; j < 4; ++j) { const u32x2 q0 = *(const MLAS u32x2*)(lds + L_Q + (t * QS + 128 * dh + 32 * j + 4 * g) * 2), q1 = *(const MLAS u32x2*)(lds + L_Q + (t * QS + 128 * dh + 32 * j + 16 + 4 * g) * 2);
                    const bf16x8 qp = __builtin_bit_cast(bf16x8, (u32x4){q0.x, q0.y, q1.x, q1.y}); accI[tb] = MMA16(cf[j], qp, accI[tb]); } }
#pragma unroll
            for (int k = 0; k < 2; ++k) *(MLAS f32x4*)(lds + L_XCH + ((w * 2 + k) * 64 + lane) * 16) = dh ? accI[k] : accI[2 + k];
        }
        MLS_LBAR();
        bf16x8 vf[2];
#pragma unroll
        for (int j = 0; j < 2; ++j) vf[j] = *(const MLAS bf16x8*)(lds + L_VT + (16 * vb + c16) * TS * 2 + (((4 * j + g) ^ ((2 * vb + (c16 >> 3)) & 7)) * 16));
#pragma unroll
        for (int k = 0; k < ((pm & 256) ? 0 : 2); ++k) { const int tb = 2 * dh + k, t = 16 * tb + c16;
            const f32x4 other = *(const MLAS f32x4*)(lds + L_XCH + (((w ^ 4) * 2 + k) * 64 + lane) * 16);
            const float wi = sm[F_WI + t];
            f32x4 acc = ((dh ? accI[2 + k] : accI[k]) + other) * wi;
#pragma unroll
            for (int j = 0; j < 2; ++j) { const bf16x8 sf = *(const MLAS bf16x8*)(lds + L_SP + (t * TS + 32 * j + 8 * g) * 2); acc = MMA16(vf[j], sf, acc); }
            const float den = sm[F_DENP + t] + sm[F_DENP + 64 + t] + wi * sm[F_NQ + t];
            const float sc = 1.0f / fmaxf(fabsf(den), sm[F_FL + t]);
            const f32x4 hv = acc * sc;
            u32x2 o; o.x = cvtpk(hv[0], hv[1]); o.y = cvtpk(hv[2], hv[3]);
            if (!(pm & 2048)) *(u32x2*)(VH + (row0 + (size_t)c * 64 + t) * DM + h * 256 + 64 * vs + 16 * vb + 4 * g) = o;
            float s1 = (hv[0] + hv[1]) + (hv[2] + hv[3]), s2 = (hv[0] * hv[0] + hv[1] * hv[1]) + (hv[2] * hv[2] + hv[3] * hv[3]);
            s1 += __shfl_xor(s1, 16); s1 += __shfl_xor(s1, 32); s2 += __shfl_xor(s2, 16); s2 += __shfl_xor(s2, 32);
            if (g == 0) { sm[F_STATP + (vb * 64 + t) * 2] = s1; sm[F_STATP + (vb * 64 + t) * 2 + 1] = s2; } }
        const float decay = sm[F_WI + 63];
#pragma unroll
        for (int nb = 0; nb < 8; ++nb) { Cacc[nb] = Cacc[nb] * decay;
            if (!(pm & 512))
#pragma unroll
            for (int j = 0; j < 2; ++j) { const bf16x8 kf = *(const MLAS bf16x8*)(lds + L_KWT + (128 * dh + 16 * nb + c16) * TS * 2 + (((4 * j + g) ^ ((2 * nb + (c16 >> 3)) & 7)) * 16)); Cacc[nb] = MMA16(kf, vf[j], Cacc[nb]); } }
        if (tid < 256 && !(pm & 1024)) { float s = 0.f;
#pragma unroll
            for (int j = 0; j < 8; ++j) { const u32x4 kv = *(const MLAS u32x4*)(lds + L_KWT + (tid * TS + 8 * j) * 2); s += (blo(kv.x) + bhi(kv.x)) + (blo(kv.y) + bhi(kv.y)) + (blo(kv.z) + bhi(kv.z)) + (blo(kv.w) + bhi(kv.w)); }
            sm[F_NVEC + tid] = decay * sm[F_NVEC + tid] + s; }
        MLS_LBAR();
    }
    if (tid0 < 64) { float s1 = 0.f, s2 = 0.f;
#pragma unroll
            for (int k = 0; k < 4; ++k) { s1 += sm[F_STATP + (k * 64 + tid0) * 2]; s2 += sm[F_STATP + (k * 64 + tid0) * 2 + 1]; }
            float* sp = stats + ((row0 + (size_t)31 * 64 + tid0) * 4 + h) * 2; unsafeAtomicAdd(sp, s1); unsafeAtomicAdd(sp + 1, s2); }
    __syncthreads();
#undef MLS_PREFETCH
}
#undef MMA16
#undef MLS_LBAR
#undef MLAS
}

constexpr int BATCH = 8, T = 2048, D = 1024, M = BATCH * T, FF = 2816, NA = 6144, NAC = 6176  , NB = 4096, NHM = 4, NHF = 16;
constexpr int NWAVES = 8;
constexpr float C2 = 0.125f * 1.4426950408889634f;
constexpr size_t MiB = 1u << 20;
constexpr size_t WS_CTL = 0, CTL_ZERO_BYTES = 1 * MiB;
constexpr size_t CTL_SS = 65536;
constexpr size_t CTL_STATS = 512 * 1024;
constexpr size_t WS_BIASA = 1 * MiB, WS_BIASB = 1 * MiB + 65536;
constexpr size_t WS_GATES = 2 * MiB;
constexpr size_t WS_XB = 8 * MiB;
constexpr size_t WS_P = 40 * MiB, SLOT = 32 * MiB;
constexpr size_t WS_H1 = 40 * MiB, WS_W1GU = 128 * MiB, WS_W1D = 140 * MiB;
constexpr size_t WS_WINA = 232 * MiB, WS_WINB = 245 * MiB;
constexpr size_t WS_Y = 40 * MiB;
constexpr size_t WS_W2GU = 232 * MiB, WS_WOUT = 243 * MiB;
constexpr size_t WS_W2D = 86 * MiB;
constexpr size_t WS_H2 = 104 * MiB;
constexpr size_t WS_END = 256 * MiB;
static_assert(WS_H1 + (size_t)M * FF * 2 <= WS_W1GU && WS_W1GU + (size_t)2 * FF * D * 2 <= WS_W1D && WS_W1D + (size_t)D * FF * 2 <= WS_WINA, "map1");
static_assert(WS_WINA + (size_t)NA * D * 2 <= WS_WINB && WS_WINB + (size_t)NB * D * 2 <= WS_END, "map2");
static_assert(WS_W2GU + (size_t)2 * FF * D * 2 <= WS_WOUT && WS_WOUT + (size_t)D * D * 2 <= WS_WINB && WS_W2D + (size_t)D * FF * 2 <= WS_H2 && WS_H2 + (size_t)M * FF * 2 <= WS_WINA, "map3");

constexpr int RING_BYTES = 131072, LDS_BYTES = 147456;
#ifndef PROBE_K
#define PROBE_K -1
#endif
#ifndef PROBE_MODE
#define PROBE_MODE 0
#endif

#define GAS __attribute__((address_space(1)))
#define LAS __attribute__((address_space(3)))
typedef unsigned short bf16;
typedef unsigned v4u __attribute__((ext_vector_type(4)));
typedef unsigned v2u __attribute__((ext_vector_type(2)));
typedef float f32x4 __attribute__((ext_vector_type(4)));
__device__ __forceinline__ unsigned f2bf(float f) { unsigned u = __builtin_bit_cast(unsigned, f); return (u + 0x7fffu + ((u >> 16) & 1u)) >> 16; }
__device__ __forceinline__ unsigned pk2(float lo, float hi) { return f2bf(lo) | (f2bf(hi) << 16); }
__device__ __forceinline__ float bf2f(bf16 v) { return __uint_as_float((unsigned)v << 16); }
__device__ __forceinline__ float wave_sum(float v) {
#pragma unroll
    for (int o = 1; o < 64; o <<= 1) v += __shfl_xor(v, o);
    return v;
}
__device__ __forceinline__ float log_sigmoid(float x) { return fminf(x, 0.f) - log1pf(expf(-fabsf(x))); }

struct Args { const float* in[17]; float* out; unsigned char* ws; int ph_lo, ph_hi, coop, mode; };

struct MatDesc { const float* s0; const float* s1; const float* scale; bf16* dst; int K, Nsrc, nrows, kind; };
__device__ __forceinline__ int inA_src(int c) {
    if (c < 6144) { const int slot = c >> 10, j = c & 1023; const int st = slot == 0 ? 0 : slot == 1 ? 1024 : slot == 2 ? 2048 : slot == 3 ? 4104 : slot == 4 ? 5128 : 6152; return st + j; }
    const int g = c - 6144; if (g < 4) return 4096 + g; if (g < 8) return 4100 + (g - 4); if (g < 24) return 7176 + (g - 8); return -1;
}
__device__ __forceinline__ int inB_src(int c) {
    const int pn = c >> 8, ct = c & 255, bj = ct >> 7, wc = (ct >> 5) & 3, fq = (ct >> 3) & 3, n = (ct >> 2) & 1, i = ct & 3, j = 64 * pn + 16 * wc + 4 * fq + i;
    if (bj == 0) return n == 0 ? 3072 + j : 7192 + j;
    return n == 0 ? 8216 + j : -1;
}
__device__ __forceinline__ const float* src_col(const MatDesc& d, int c) {
    if (d.kind == 0) { const int pn = c >> 8, bj = (c >> 7) & 1, r = c & 127; const long long dl = (long long)((const char*)d.s1 - (const char*)d.s0) * bj; return (const float*)((const char*)d.s0 + dl) + 128 * pn + r; }
    if (d.kind == 1) return d.s0 + c;
    const int s = d.kind == 2 ? inA_src(c) : inB_src(c); return s < 0 ? nullptr : d.s0 + s;
}
__device__ __forceinline__ void transpose_item(const MatDesc& d, LAS float* scr, int item, int lane) {
    const int nblk = d.nrows / 32, kb = item / nblk, nb = item % nblk, k0 = 64 * kb, n0 = 32 * nb;
    const int q4 = lane & 7, kr = lane >> 3;
    const float* sp = src_col(d, n0 + 4 * q4);
#pragma unroll
    for (int i = 0; i < 8; ++i) { const int kk = kr + 8 * i; f32x4 v = {0.f, 0.f, 0.f, 0.f};
        if (sp) { v = __builtin_nontemporal_load((const f32x4*)(sp + (size_t)(k0 + kk) * d.Nsrc)); if (d.scale) v = v * d.scale[k0 + kk]; }
        scr[kk * 33 + 4 * q4] = v.x; scr[kk * 33 + 4 * q4 + 1] = v.y; scr[kk * 33 + 4 * q4 + 2] = v.z; scr[kk * 33 + 4 * q4 + 3] = v.w; }
    asm volatile("s_waitcnt lgkmcnt(0)" ::: "memory");
    const int c = lane & 7;
#pragma unroll
    for (int j = 0; j < 4; ++j) { const int n = (lane >> 3) + 8 * j; const LAS float* s = scr + (8 * c) * 33 + n;
        v4u o; o.x = pk2(s[0 * 33], s[1 * 33]); o.y = pk2(s[2 * 33], s[3 * 33]); o.z = pk2(s[4 * 33], s[5 * 33]); o.w = pk2(s[6 * 33], s[7 * 33]);
        *(GAS v4u*)(d.dst + (size_t)(n0 + n) * d.K + k0 + 8 * c) = o; }
    asm volatile("s_waitcnt lgkmcnt(0)" ::: "memory");
}
__device__ __forceinline__ void convert_mat(const MatDesc d, LAS unsigned char* lds, int gw, int NGW, int wave, int lane) {
    LAS float* scr = (LAS float*)(lds + wave * 16384); const int nitems = (d.K / 64) * (d.nrows / 32);
#pragma unroll 1
    for (int it = gw; it < nitems; it += NGW) transpose_item(d, scr, it, lane);
}

constexpr size_t WS_FTAB = 4 * MiB;
constexpr size_t WS_MTAB = 253 * MiB;
__device__ __forceinline__ void conv_item(int item, bf16* P, const float* conv_w, const float* conv_b, int tid) {
    const int b = item >> 5, cgp = item & 31, cc = tid & 7, seg = tid >> 3;
    const int ch0 = 64 * cgp + 8 * cc, slot = ch0 >> 10, col = ch0 & 1023; const float osc = slot ? 0.0625f : 1.0f;
    bf16* base = P + (size_t)slot * M * D + ((size_t)b * T + 32 * seg) * D + col;
    float w0[8], w1[8], w2[8], w3[8], bb[8];
#pragma unroll
    for (int e = 0; e < 8; ++e) { w0[e] = conv_w[ch0 + e]; w1[e] = conv_w[2048 + ch0 + e]; w2[e] = conv_w[4096 + ch0 + e]; w3[e] = conv_w[6144 + ch0 + e]; bb[e] = conv_b[ch0 + e]; }
    v4u h0 = {0u, 0u, 0u, 0u}, h1 = h0, h2 = h0;
    if (seg > 0) { h0 = *(const v4u*)(base - 3 * D); h1 = *(const v4u*)(base - 2 * D); h2 = *(const v4u*)(base - 1 * D); }
    asm volatile("s_waitcnt vmcnt(0)" ::: "memory");
    __syncthreads();
#pragma unroll 4
    for (int r = 0; r < 32; ++r) { const v4u cur = *(const v4u*)(base + (size_t)r * D); v4u o;
#pragma unroll
        for (int e2 = 0; e2 < 4; ++e2) { const int e = 2 * e2;
            float ya = bb[e] + w0[e] * pg8::bf_lo(h0[e2]) + w1[e] * pg8::bf_lo(h1[e2]) + w2[e] * pg8::bf_lo(h2[e2]) + w3[e] * pg8::bf_lo(cur[e2]);
            float yb = bb[e + 1] + w0[e + 1] * pg8::bf_hi(h0[e2]) + w1[e + 1] * pg8::bf_hi(h1[e2]) + w2[e + 1] * pg8::bf_hi(h2[e2]) + w3[e + 1] * pg8::bf_hi(cur[e2]);
            ya = ya * pg8::sigm(ya) * osc; yb = yb * pg8::sigm(yb) * osc; o[e2] = pk2(ya, yb); }
        *(v4u*)(base + (size_t)r * D) = o; h0 = h1; h1 = h2; h2 = cur; }
    __syncthreads();
}
__device__ __forceinline__ void ftab_item(int bh, const float* gates, v4u* ftab, LAS float* wt, int tid, int lane, int wave) {
    const int b = bh >> 4, h = bh & 15;
    float vv[4]; float s = 0.f;
#pragma unroll
    for (int i = 0; i < 4; ++i) { vv[i] = log_sigmoid(gates[((size_t)b * T + 4 * tid + i) * 32 + 8 + h]); s += vv[i]; vv[i] = s; }
    float x = s;
#pragma unroll
    for (int o = 1; o < 64; o <<= 1) { const float y = __shfl_up(x, o); if (lane >= o) x += y; }
    if (lane == 63) wt[wave] = x;
    __syncthreads();
    float off = 0.f;
#pragma unroll
    for (int k = 0; k < NWAVES; ++k) { const float t_ = wt[k]; if (k < wave) off += t_; }
    const float base = off + x - s;
#pragma unroll
    for (int i = 0; i < 4; ++i) { const float xb = -(vv[i] + base) * 1.4426950408889634f;
        const unsigned h0 = f2bf(xb); const float r0 = xb - __uint_as_float(h0 << 16); const unsigned m0 = f2bf(r0); const float q0 = r0 - __uint_as_float(m0 << 16); const unsigned l0 = f2bf(q0);
        v4u o4; o4.x = h0 | (m0 << 16); o4.y = l0 | 0x3f800000u; o4.z = 0x3f803f80u; o4.w = 0u;
        ftab[(size_t)bh * T + 4 * tid + i] = o4; }
    __syncthreads();
}
__device__ __forceinline__ void mtab_item(int bh, const float* gates, float* mtab, int lane) {
    const int b = bh >> 2, h = bh & 3; float mprev = 0.f; float* mt = mtab + (size_t)bh * 5 * T;
    float liv[32], lfv[32];
#pragma unroll
    for (int c = 0; c < 32; ++c) { const size_t row = (size_t)b * T + c * 64 + lane; liv[c] = gates[row * 32 + h]; lfv[c] = gates[row * 32 + 4 + h]; }
#pragma unroll
    for (int c = 0; c < 32; ++c) { const int t = c * 64 + lane;
        const float li = liv[c], lf = log_sigmoid(lfv[c]);
        float bc = lf;
#pragma unroll
        for (int o = 1; o < 64; o <<= 1) { const float y = __shfl_up(bc, o); if (lane >= o) bc += y; }
        const float a = li - bc; float cm = a;
#pragma unroll
        for (int o = 1; o < 64; o <<= 1) { const float y = __shfl_up(cm, o); if (lane >= o) cm = fmaxf(cm, y); }
        const float r = fmaxf(mprev, cm), r63 = __shfl(r, 63), b63 = __shfl(bc, 63);
        mt[t] = a * 1.4426950408889634f; mt[T + t] = r * 1.4426950408889634f; mt[2 * T + t] = expf(mprev - r); mt[3 * T + t] = expf(-(bc + r)); mt[4 * T + t] = expf(a - r63);
        mprev = b63 + r63; }
}

#define RLX_AGENT __ATOMIC_RELAXED, __HIP_MEMORY_SCOPE_AGENT
#define XB_TMO      128
#define XB_XCNT(j)  (256  + 64 * (j))
#define XB_XSUB(j)  (1280 + 64 * (j))
#define XB_XGEN(j)  (2304 + 64 * (j))
#define XB_TOP      3328
#define XB_TOPGEN   3392
#define XCD_BAR_WORDS 3456
#define XB_SPIN_CAP (1u << 18)

__device__ __forceinline__ unsigned xb_ld(unsigned* p)              { return __hip_atomic_load(p, __ATOMIC_RELAXED, __HIP_MEMORY_SCOPE_AGENT); }
__device__ __forceinline__ unsigned xb_add(unsigned* p, unsigned v) { return __hip_atomic_fetch_add(p, v, __ATOMIC_RELAXED, __HIP_MEMORY_SCOPE_AGENT); }
__device__ __forceinline__ unsigned xb_xcc_id() { return (unsigned)__builtin_amdgcn_s_getreg((3 << 11) | 20) & 0xFu; }
#define XB_SPIN(cond, bar) do { unsigned _sp = 0; while (cond) { __builtin_amdgcn_s_sleep(1); \
    if ((++_sp & 255u) == 0u) { if (xb_ld(&(bar)[XB_TMO])) break; if (_sp > XB_SPIN_CAP) { atomicAdd(&(bar)[XB_TMO], 1u); break; } } } } while (0)

struct XcdBarrier {
    unsigned* bar; unsigned x;
    volatile LAS unsigned* st;
};

__device__ __forceinline__ XcdBarrier xcd_barrier_post(unsigned* bar, volatile LAS unsigned* st) {
    XcdBarrier b; b.bar = bar; b.x = xb_xcc_id(); b.st = st;
    if (threadIdx.x == 0) (void)xb_add(&bar[XB_XCNT(b.x)], 1u);
    return b;
}
__device__ __forceinline__ void xcd_barrier_complete(unsigned* bar, unsigned x, unsigned& nloc, unsigned& nx) {
    const unsigned G = gridDim.x * gridDim.y * gridDim.z;
    unsigned sum, cnt, mine, sp = 0u;
    for (;;) {
        sum = 0u; cnt = 0u; mine = 0u;
#pragma unroll
        for (unsigned j = 0; j < 16; ++j) { const unsigned c = xb_ld(&bar[XB_XCNT(j)]); sum += c; cnt += (c > 0u) ? 1u : 0u; mine = (j == x) ? c : mine; }
        if (sum == G) break;
        __builtin_amdgcn_s_sleep(1);
        if ((++sp & 255u) == 0u) { if (xb_ld(&bar[XB_TMO])) break; if (sp > XB_SPIN_CAP) { atomicAdd(&bar[XB_TMO], 1u); break; } }
    }
    nloc = mine > 0u ? mine : 1u; nx = cnt > 0u ? cnt : 1u;
}

__device__ __forceinline__ void xcd_barrier(const XcdBarrier& b) {
    asm volatile("s_waitcnt vmcnt(0)" ::: "memory");
    __syncthreads();
    if (threadIdx.x == 0) {
        unsigned* bar = b.bar;
        __builtin_amdgcn_s_waitcnt(0);
        unsigned nloc = b.st[0], nx = b.st[1];
        if (nloc == 0u) { xcd_barrier_complete(bar, b.x, nloc, nx); b.st[0] = nloc; b.st[1] = nx; }
        const unsigned old = xb_add(&bar[XB_XSUB(b.x)], 1u);
        const unsigned gen = old / nloc;
        if (old + 1u == (gen + 1u) * nloc) {
            __builtin_amdgcn_fence(__ATOMIC_RELEASE, "agent");
            asm volatile("s_waitcnt vmcnt(0)" ::: "memory");
            const unsigned og = xb_add(&bar[XB_TOP], 1u);
            const unsigned tg = og / nx;
            if (og + 1u == (tg + 1u) * nx) xb_add(&bar[XB_TOPGEN], 1u);
            else XB_SPIN(xb_ld(&bar[XB_TOPGEN]) == tg, bar);
            __builtin_amdgcn_fence(__ATOMIC_ACQUIRE, "agent");
            xb_add(&bar[XB_XGEN(b.x)], 1u);
            asm volatile("s_waitcnt vmcnt(0)" ::: "memory");
        } else {
            XB_SPIN(xb_ld(&bar[XB_XGEN(b.x)]) == gen, bar);
            __builtin_amdgcn_fence(__ATOMIC_ACQUIRE, "agent");
            asm volatile("s_waitcnt vmcnt(0)" ::: "memory");
        }
    }
    __syncthreads();
}

__global__ void __launch_bounds__(NWAVES * 64, 2) mk_fwd(Args args) {
    __builtin_assume(__builtin_amdgcn_workitem_id_y() == 0); __builtin_assume(__builtin_amdgcn_workitem_id_z() == 0);
    extern __shared__ __attribute__((aligned(16))) unsigned char lds_raw[];
    LAS unsigned char* lds = (LAS unsigned char*)lds_raw;
    const int tid = threadIdx.x, lane = tid & 63, wave = __builtin_amdgcn_readfirstlane(tid >> 6);
    const int G = gridDim.x, gw = blockIdx.x * NWAVES + wave, NGW = G * NWAVES;
    unsigned char* ws = args.ws;
    float* ctlf = (float*)(ws + WS_CTL);
    float* SS0 = (float*)(ws + CTL_SS * 1); float* SS1 = (float*)(ws + CTL_SS * 2); float* SS2 = (float*)(ws + CTL_SS * 3); float* SS3 = (float*)(ws + CTL_SS * 4);
    float* STATS = (float*)(ws + CTL_STATS);
    float* BIASA = (float*)(ws + WS_BIASA); float* BIASB = (float*)(ws + WS_BIASB); float* GATES = (float*)(ws + WS_GATES);
    bf16* XB = (bf16*)(ws + WS_XB); bf16* P = (bf16*)(ws + WS_P);
    const int lo = args.ph_lo, hi = args.ph_hi;
    volatile LAS unsigned* xst = (volatile LAS unsigned*)(lds + LDS_BYTES - 64);
    if (tid < 2) xst[tid] = 0u;
    __syncthreads();
    for (int i = blockIdx.x * (NWAVES * 64) + tid; i < (int)(CTL_ZERO_BYTES / 4); i += G * (NWAVES * 64)) ((unsigned*)(ws + WS_CTL))[i] = 0u;
    cooperative_groups::this_grid().sync();
    XcdBarrier xbar = xcd_barrier_post((unsigned*)(ws + WS_CTL) + 8192 + (args.coop > 1 ? XCD_BAR_WORDS : 0), xst);
#define IN(k) (lo <= (k) && (k) < hi)
#define SEAM(k) do { if (IN(k) && IN((k) + 1)) { xcd_barrier(xbar); } } while (0)
    (void)ctlf;
    if (IN(0)) {
        convert_mat(MatDesc{args.in[2], args.in[3], args.in[1], (bf16*)(ws + WS_W1GU), D, FF, 2 * FF, 0}, lds, gw, NGW, wave, lane);
        if (G <= BATCH * NHF) convert_mat(MatDesc{args.in[6], nullptr, args.in[5], (bf16*)(ws + WS_WINB), D, 9240, NB, 3}, lds, gw, NGW, wave, lane);
        for (int c = blockIdx.x * 512 + tid; c < NAC + NB; c += G * 512) {
            if (c < NAC) { const int s = inA_src(c); BIASA[c] = s < 0 ? 0.f : args.in[7][s]; } else { const int s = inB_src(c - NAC); BIASB[c - NAC] = s < 0 ? 0.f : args.in[7][s]; } }
        for (int m0 = gw; m0 < M; m0 += 4 * NGW) {
            f32x4 v[4][4];
#pragma unroll
            for (int r = 0; r < 4; ++r) { const int m = m0 + r * NGW; if (m < M) { const GAS f32x4* xr = (const GAS f32x4*)(args.in[0] + (size_t)m * D) + lane;
#pragma unroll
                for (int j = 0; j < 4; ++j) v[r][j] = xr[64 * j]; } }
#pragma unroll
            for (int r = 0; r < 4; ++r) { const int m = m0 + r * NGW; if (m < M) { GAS unsigned long long* o8 = (GAS unsigned long long*)(XB + (size_t)m * D) + lane; float s = 0.f;
#pragma unroll
                for (int j = 0; j < 4; ++j) { const f32x4 t = v[r][j]; s += (t.x * t.x + t.y * t.y) + (t.z * t.z + t.w * t.w); o8[64 * j] = (unsigned long long)pk2(t.x, t.y) | ((unsigned long long)pk2(t.z, t.w) << 32); }
                s = wave_sum(s); if (lane == 0) SS0[m] = s; } } }
    }
    SEAM(0);
    if (IN(1)) { pg8::Gemm g{XB, (const bf16*)(ws + WS_W1GU), M, 2 * FF, D}; pg8::StaticOrder S; S.init(M, 2 * FF, G, (int)blockIdx.x);
        pg8::EpiSwiGLU E{(bf16*)(ws + WS_H1), FF, SS0};
        pg8::gemm_phase<pg8::EpiSwiGLU, pg8::StaticOrder, true, true>(lds, g, S, E);
        { const int rem = ((M / 256) * (2 * FF / 256)) % G, fb = rem == 0 ? 0 : rem;
          if ((int)blockIdx.x >= fb) { const int gw2 = ((int)blockIdx.x - fb) * NWAVES + wave, ngw2 = (G - fb) * NWAVES;
              convert_mat(MatDesc{args.in[4], nullptr, nullptr, (bf16*)(ws + WS_W1D), FF, D, D, 1}, lds, gw2, ngw2, wave, lane);
              convert_mat(MatDesc{args.in[6], nullptr, args.in[5], (bf16*)(ws + WS_WINA), D, 9240, NAC, 2}, lds, gw2, ngw2, wave, lane); } } }
    SEAM(1);
    if (IN(2)) { pg8::Gemm g{(const bf16*)(ws + WS_H1), (const bf16*)(ws + WS_W1D), M, D, FF}; pg8::StaticOrder S; S.init(M, D, G, (int)blockIdx.x);
        pg8::EpiResid E{args.in[0], args.out, XB, SS1, 0.5f};
        pg8::gemm_phase<pg8::EpiResid, pg8::StaticOrder, true, true>(lds, g, S, E); }
    SEAM(2);
    if (IN(3)) {
        { typedef short bf16x8_t __attribute__((ext_vector_type(8))); const int c16 = lane & 15, gq = lane >> 4, cb = wave >> 2, col = 16 * cb + c16;
            const bf16* wrow = (const bf16*)(ws + WS_WINA) + (size_t)(6144 + col) * D + 8 * gq;
#pragma unroll 1
            for (int item = blockIdx.x * 4 + (wave & 3); item < M / 16; item += G * 4) { const bf16* xr = XB + (size_t)(item * 16 + c16) * D + 8 * gq;
                bf16x8_t a[32];
#pragma unroll
                for (int j = 0; j < 32; ++j) a[j] = *(const bf16x8_t*)(xr + 32 * j);
                f32x4 acc0 = {0.f, 0.f, 0.f, 0.f};
#pragma unroll
                for (int jb = 0; jb < 2; ++jb) { bf16x8_t b0[16];
#pragma unroll
                    for (int j = 0; j < 16; ++j) b0[j] = *(const bf16x8_t*)(wrow + 32 * (16 * jb + j));
#pragma unroll
                    for (int j = 0; j < 16; ++j) acc0 = __builtin_amdgcn_mfma_f32_16x16x32_bf16(a[16 * jb + j], b0[j], acc0, 0, 0, 0); }
                const float bc0 = BIASA[6144 + col];
                if (col < 24) {
#pragma unroll
                    for (int i = 0; i < 4; ++i) { const int r = item * 16 + 4 * gq + i; const float rs = __builtin_amdgcn_rsqf(SS1[r] * (1.f / D) + 1e-6f);
                        GATES[(size_t)r * 32 + col] = acc0[i] * rs + bc0; } } } }
        pg8::Gemm g{XB, (const bf16*)(ws + WS_WINA), M, NA, D}; pg8::StaticOrder S; S.init(M, NA, G, (int)blockIdx.x);
        pg8::EpiInA E{P, (size_t)M * D, GATES, BIASA, SS1, C2};
        pg8::gemm_phase<pg8::EpiInA, pg8::StaticOrder, true, true>(lds, g, S, E); }
    SEAM(3);
    if (IN(4)) {
#pragma unroll 1
        for (int it = blockIdx.x; it < BATCH * 32; it += G) conv_item(it, P, args.in[8], args.in[9], tid);
#pragma unroll 1
        for (int it = blockIdx.x; it < BATCH * NHF; it += G) ftab_item(it, GATES, (v4u*)(ws + WS_FTAB), (LAS float*)lds, tid, lane, wave);
#pragma unroll 1
        for (int it = blockIdx.x; it < BATCH * NHM; it += G) if (wave == NWAVES - 1) mtab_item(it, GATES, (float*)(ws + WS_MTAB), lane);
        { const int fb = G > BATCH * NHF ? BATCH * NHF : 0;
          if (fb && (int)blockIdx.x >= BATCH * NHM && (int)blockIdx.x < fb)
              convert_mat(MatDesc{args.in[6], nullptr, args.in[5], (bf16*)(ws + WS_WINB), D, 9240, NB, 3}, lds, ((int)blockIdx.x - BATCH * NHM) * NWAVES + wave, (fb - BATCH * NHM) * NWAVES, wave, lane);
          if ((int)blockIdx.x >= fb) { const int gw2 = ((int)blockIdx.x - fb) * NWAVES + wave, ngw2 = (G - fb) * NWAVES;
              convert_mat(MatDesc{args.in[13], args.in[14], args.in[12], (bf16*)(ws + WS_W2GU), D, FF, 2 * FF, 0}, lds, gw2, ngw2, wave, lane);
              convert_mat(MatDesc{args.in[11], nullptr, nullptr, (bf16*)(ws + WS_WOUT), D, D, D, 1}, lds, gw2, ngw2, wave, lane); } }
    }
    SEAM(4);
    if (IN(5)) {
#pragma unroll 1
        for (int x = blockIdx.x; x < ((args.mode & 1) ? 0 : 128); x += G) { const int pr = ((x >> 3) >> 2) + 4 * (x & 7), vs = (x >> 3) & 3;
            mls::mlstm_unit(pr >> 2, pr & 3, vs, P, P + (size_t)M * D, P + 2 * (size_t)M * D, (const float*)(ws + WS_MTAB), STATS, lds, args.mode); }
        const attn_body::bf16* Qp = (const attn_body::bf16*)(P + 3 * (size_t)M * D); const attn_body::bf16* Kp = (const attn_body::bf16*)(P + 4 * (size_t)M * D); const attn_body::bf16* Vp = (const attn_body::bf16*)(P + 5 * (size_t)M * D);
        volatile LAS unsigned* qslot = (volatile LAS unsigned*)(lds + attn_body::ATTN_LDS_BYTES);
        int qsel = 0;
#pragma unroll 1
        for (;;) {
            if (args.mode & 2) break;
            const int xq = ((int)blockIdx.x + qsel) & 7;
            if (tid == 0) *qslot = atomicAdd((unsigned*)(ws + WS_CTL) + 64 * xq, 1u);
            __syncthreads();
            const unsigned idx = *qslot;
            __syncthreads();
            if (idx >= 128u) { if (++qsel == 8) break; continue; }
            const int i2 = (int)(idx & 63u), qb = (idx < 64u ? 7 : 3) - (i2 & 3), bh = (i2 >> 2) * 8 + xq, b = bh >> 4, h = bh & 15;
            { int tid_ = tid; asm volatile("" : "+v"(tid_));
              const v4u* src = (const v4u*)(ws + WS_FTAB) + (size_t)bh * T; LAS v4u* dst = (LAS v4u*)(lds + attn_body::LDS_CB);
              const int ne = 256 * (qb + 1); v4u tb[4];
#pragma unroll
              for (int k = 0; k < 4; ++k) { const int e = tid_ + k * NWAVES * 64; if (e < ne) tb[k] = src[e]; }
#pragma unroll
              for (int k = 0; k < 4; ++k) { const int e = tid_ + k * NWAVES * 64; if (e < ne) dst[e] = tb[k]; } }
            __syncthreads();
            attn_body::attn_unit<56>(b, h, qb, Qp, Kp, Vp, (attn_body::bf16*)Qp, (char*)lds_raw);
        }
    }
    SEAM(5);
    if (IN(6)) {
        pg8::Gemm g{XB, (const bf16*)(ws + WS_WINB), M, NB, D}; pg8::StaticOrder S; S.init(M, NB, G, (int)blockIdx.x);
        pg8::EpiInB E{P + 2 * (size_t)M * D, P + 3 * (size_t)M * D, STATS, args.in[10], BIASB, SS1, (bf16*)(ws + WS_Y)};
        pg8::gemm_phase<pg8::EpiInB, pg8::StaticOrder, true, true>(lds, g, S, E); }
    SEAM(6);
    if (IN(7)) { pg8::Gemm g{(const bf16*)(ws + WS_Y), (const bf16*)(ws + WS_WOUT), M, D, D}; pg8::StaticOrder S; S.init(M, D, G, (int)blockIdx.x);
        pg8::EpiResid E{args.out, args.out, XB, SS2, 1.0f};
        pg8::gemm_phase<pg8::EpiResid, pg8::StaticOrder, true, true>(lds, g, S, E); }
    SEAM(7);
    if (IN(8)) { pg8::Gemm g{XB, (const bf16*)(ws + WS_W2GU), M, 2 * FF, D}; pg8::StaticOrder S; S.init(M, 2 * FF, G, (int)blockIdx.x);
        pg8::EpiSwiGLU E{(bf16*)(ws + WS_H2), FF, SS2};
        pg8::gemm_phase<pg8::EpiSwiGLU, pg8::StaticOrder, true, true>(lds, g, S, E);
        { const int rem = ((M / 256) * (2 * FF / 256)) % G, fb = rem == 0 ? 0 : rem;
          if ((int)blockIdx.x >= fb) convert_mat(MatDesc{args.in[15], nullptr, nullptr, (bf16*)(ws + WS_W2D), FF, D, D, 1}, lds, ((int)blockIdx.x - fb) * NWAVES + wave, (G - fb) * NWAVES, wave, lane); } }
    SEAM(8);
    if (IN(9)) { pg8::Gemm g{(const bf16*)(ws + WS_H2), (const bf16*)(ws + WS_W2D), M, D, FF}; pg8::StaticOrder S; S.init(M, D, G, (int)blockIdx.x);
        pg8::EpiResidNorm E{args.out, args.out, SS3, (unsigned*)(ws + WS_CTL) + 2048, args.in[16], 0.5f};
        pg8::gemm_phase<pg8::EpiResidNorm, pg8::StaticOrder, true, true>(lds, g, S, E); }
#undef IN
#undef SEAM
}

extern "C" void kernel_launch(void* const* d_in, const int* in_sizes, int n_in, void* d_out, int out_size, void* d_ws, size_t ws_size, hipStream_t stream) {
    static int ready = 0;
    if (!ready) { if (hipFuncSetAttribute((const void*)mk_fwd, hipFuncAttributeMaxDynamicSharedMemorySize, LDS_BYTES) != hipSuccess) { fprintf(stderr, "hipFuncSetAttribute failed\n"); } ready = 1; }
    if (n_in != 17 || ws_size < WS_END) { fprintf(stderr, "kernel_launch: unexpected n_in %d / ws %zu\n", n_in, ws_size); return; }
    Args a{};
    for (int i = 0; i < 17; ++i) a.in[i] = (const float*)d_in[i];
    a.out = (float*)d_out; a.ws = (unsigned char*)d_ws; a.coop = 0;
    static int grid = 0;
    if (!grid) { int dev = 0, cus = 0, per_cu = 0; hipGetDevice(&dev); hipDeviceGetAttribute(&cus, hipDeviceAttributeMultiprocessorCount, dev);
        hipOccupancyMaxActiveBlocksPerMultiprocessor(&per_cu, (const void*)mk_fwd, NWAVES * 64, LDS_BYTES);
        grid = cus * (per_cu < 1 ? 1 : 1); if (per_cu < 1) fprintf(stderr, "occupancy query says %d blocks/CU\n", per_cu); }
    void* kargs[] = {&a};
#if PROBE_K >= 0
    a.ph_lo = 0; a.ph_hi = PROBE_K + 1; a.coop = 2; a.mode = PROBE_MODE;
    (void)hipLaunchCooperativeKernel((const void*)mk_fwd, dim3(grid), dim3(NWAVES * 64), kargs, LDS_BYTES, stream);
#endif
    a.ph_lo = 0; a.ph_hi = 11; a.coop = 1; a.mode = 0;
    hipError_t e = hipLaunchCooperativeKernel((const void*)mk_fwd, dim3(grid), dim3(NWAVES * 64), kargs, LDS_BYTES, stream);
    if (e != hipSuccess) fprintf(stderr, "cooperative launch failed: %s (grid %d)\n", hipGetErrorString(e), grid);
}
```
